# Optimizing an MI355X kernel written in HIP

```python
import jax, jax.numpy as jnp
from jax import lax
import numpy as np

D_MODEL = 1024
BATCH = 8
SEQ = 2048
DEPTH = 4

CTX_LEN = 256
GRID_W = 64
N_MIXERS = 3
ALPHA = (2 * DEPTH) ** 0.25
BETA = (8 * DEPTH) ** -0.25
LN_EPS = 1e-6
RMS_EPS = 1e-6
N_MOD = 6
FFN_HIDDEN = -(-8 * D_MODEL // (3 * 256)) * 256
POOL_WINDOWS = (2, 4, 8, 16)
N_POOL_GROUPS = len(POOL_WINDOWS)
POOL_GROUP_DIM = D_MODEL // N_POOL_GROUPS
HGRN_HEAD_DIM = 128
HGRN_HEADS = D_MODEL // HGRN_HEAD_DIM
HGRN_CHUNK = 64
NA_HEAD_DIM = 64
NA_HEADS = D_MODEL // NA_HEAD_DIM
NA_ROWS = 8
NA_COLS = 16
NA_QBLOCK = 16
NA_KBAND = 32
N_POOL_LAYERS = len(range(0, DEPTH, N_MIXERS))
N_HGRN_LAYERS = len(range(1, DEPTH, N_MIXERS))
N_NA_LAYERS = len(range(2, DEPTH, N_MIXERS))

kernel_name = 'hybrid_pool_hgrn2_natten_dit_trunk'


def layer_norm(x, g, b):
    xf = x.astype(jnp.float32)
    mu = jnp.mean(xf, axis=-1, keepdims=True)
    var = jnp.mean(jnp.square(xf - mu), axis=-1, keepdims=True)
    return ((xf - mu) * lax.rsqrt(var + LN_EPS) * g + b).astype(x.dtype)


def swiglu(h, w_in, w_out):
    gt, up = jnp.split(h @ w_in, 2, axis=-1)
    return (jax.nn.silu(gt) * up) @ w_out


def centred_window_mean(h, w):
    L = h.shape[1]
    lo = w // 2
    hi = w - 1 - lo
    t = np.arange(L)
    start = np.clip(t - lo, 0, L)
    end = np.clip(t + hi + 1, 0, L)
    hf = h.astype(jnp.float32)
    cs = jnp.concatenate([jnp.zeros_like(hf[:, :1]), jnp.cumsum(hf, axis=1)], axis=1)
    cnt = jnp.asarray((end - start).astype(np.float32))
    return ((cs[:, end] - cs[:, start]) / cnt[None, :, None]).astype(h.dtype)


def multiscale_pool(h, w_group, scale):
    B, L, D = h.shape
    outs = []
    for g, w in enumerate(POOL_WINDOWS):
        hg = h[..., g * POOL_GROUP_DIM:(g + 1) * POOL_GROUP_DIM]
        outs.append(centred_window_mean(hg, w) - hg)
    p = jnp.stack(outs, axis=2)
    y = jnp.einsum('blgc,gcd->blgd', p, w_group).reshape(B, L, D)
    return y * scale


def pool_mixer(hx, hc, w_group, scale, need_ctx):
    ox = multiscale_pool(hx, w_group, scale)
    oc = multiscale_pool(hc, w_group, scale) if need_ctx else None
    return ox, oc


def chunk_gated_scan(q, k, v, log_f, s0):
    B, H, L, DK = q.shape
    DV = v.shape[-1]
    C = HGRN_CHUNK
    n = L // C

    def chunks(a):
        return jnp.moveaxis(a.reshape(B, H, n, C, a.shape[-1]), 2, 0)

    lower = jnp.asarray(np.tril(np.ones((C, C), dtype=bool)))

    def step(s, inp):
        q_c, k_c, v_c, g_c = inp
        b = jnp.cumsum(g_c, axis=2)
        rel = jnp.where(lower[:, :, None], b[:, :, :, None, :] - b[:, :, None, :, :], -jnp.inf)
        a = jnp.einsum('bhtd,bhsd,bhtsd->bhts', q_c, k_c, jnp.exp(rel))
        o = jnp.einsum('bhts,bhse->bhte', a, v_c) + jnp.einsum('bhtd,bhde->bhte', q_c * jnp.exp(b), s)
        b_end = b[:, :, -1:, :]
        s_new = jnp.exp(b_end)[:, :, 0, :, None] * s + jnp.einsum('bhsd,bhse->bhde', k_c * jnp.exp(b_end - b), v_c)
        return s_new, o

    s_fin, o = lax.scan(step, s0, (chunks(q), chunks(k), chunks(v), chunks(log_f)))
    o = jnp.moveaxis(o, 0, 2).reshape(B, H, L, DV)
    return o, s_fin


def hgrn2_mixer(hx, hc, w_in, lb_fwd, lb_bwd, norm_w, w_out, need_ctx):
    def heads(a):
        B_, L_, _ = a.shape
        return a.reshape(B_, L_, HGRN_HEADS, HGRN_HEAD_DIM).transpose(0, 2, 1, 3).astype(jnp.float32)

    def project(h):
        q, v, zf, zb, g = jnp.split(h @ w_in, 5, axis=-1)
        return heads(jax.nn.silu(q)), heads(v), heads(zf), heads(zb), g

    def gate(z, lb):
        lb = lb.reshape(HGRN_HEADS, 1, HGRN_HEAD_DIM)
        f = lb + (1.0 - lb) * jax.nn.sigmoid(z)
        return 1.0 - f, jnp.log(f)

    def flip(a):
        return jnp.flip(a, axis=2)

    qx, vx, zfx, zbx, gx = project(hx)
    qc, vc, zfc, zbc, gc = project(hc)
    s0 = jnp.zeros((hc.shape[0], HGRN_HEADS, HGRN_HEAD_DIM, HGRN_HEAD_DIM), jnp.float32)
    kcf, lcf = gate(zfc, lb_fwd)
    kxf, lxf = gate(zfx, lb_fwd)
    oc_f, sc_f = chunk_gated_scan(qc, kcf, vc, lcf, s0)
    ox_f, _ = chunk_gated_scan(qx, kxf, vx, lxf, sc_f)
    kcb, lcb = gate(zbc, lb_bwd)
    kxb, lxb = gate(zbx, lb_bwd)
    oc_b, sc_b = chunk_gated_scan(flip(qc), flip(kcb), flip(vc), flip(lcb), s0)
    ox_b, _ = chunk_gated_scan(flip(qx), flip(kxb), flip(vx), flip(lxb), sc_b)

    def readout(o, g, dtype):
        B_, H_, L_, E_ = o.shape
        o = o * lax.rsqrt(jnp.mean(o * o, axis=-1, keepdims=True) + RMS_EPS)
        o = o.transpose(0, 2, 1, 3).reshape(B_, L_, H_ * E_).astype(dtype)
        return (o * norm_w * jax.nn.silu(g)) @ w_out

    ox = readout(ox_f + flip(ox_b), gx, hx.dtype)
    oc = readout(oc_f + flip(oc_b), gc, hc.dtype) if need_ctx else None
    return ox, oc


def na_mixer(hx, hc, w_qkv, rpb, w_out, need_ctx):
    B, L, D = hx.shape
    rows = L // GRID_W
    kr = min(NA_ROWS, rows)
    scale = NA_HEAD_DIM ** -0.5

    def qkv(h):
        B_, L_, _ = h.shape
        z = (h @ w_qkv).reshape(B_, L_, 3, NA_HEADS, NA_HEAD_DIM)
        return [jnp.moveaxis(z[:, :, m], 1, 2) for m in range(3)]

    qx, kx, vx = qkv(hx)
    qc, kc, vc = qkv(hc)

    def grid(a):
        return a.reshape(B, NA_HEADS, rows, GRID_W, NA_HEAD_DIM)

    qg, kg, vg = grid(qx), grid(kx), grid(vx)
    n_cb = GRID_W // NA_QBLOCK
    qcol = np.arange(GRID_W).reshape(n_cb, NA_QBLOCK)
    band_start = np.clip(np.arange(n_cb) * NA_QBLOCK - NA_COLS // 2, 0, GRID_W - NA_KBAND)
    kcol = band_start[:, None] + np.arange(NA_KBAND)
    win_start = np.clip(qcol - NA_COLS // 2, 0, GRID_W - NA_COLS)
    col_ok = (kcol[:, None, :] >= win_start[:, :, None]) & (kcol[:, None, :] < win_start[:, :, None] + NA_COLS)
    dcol_idx = np.clip(kcol[:, None, :] - qcol[:, :, None] + NA_COLS - 1, 0, 2 * NA_COLS - 2)
    col_ok = jnp.asarray(col_ok)
    n_loc = kr * NA_KBAND

    def row_block(r):
        rs = jnp.clip(r - kr // 2, 0, rows - kr)
        q_r = lax.dynamic_index_in_dim(qg, r, axis=2, keepdims=False)
        k_r = lax.dynamic_slice_in_dim(kg, rs, kr, axis=2)[:, :, :, kcol]
        v_r = lax.dynamic_slice_in_dim(vg, rs, kr, axis=2)[:, :, :, kcol]
        q_b = q_r.reshape(B, NA_HEADS, n_cb, NA_QBLOCK, NA_HEAD_DIM)
        s_loc = jnp.einsum('bhjqd,bhajkd->bhjqak', q_b, k_r).astype(jnp.float32) * scale
        drow = rs + jnp.arange(kr) - r + NA_ROWS - 1
        bias = rpb[:, drow][:, :, dcol_idx].transpose(0, 2, 3, 1, 4)
        s_loc = jnp.where(col_ok[:, :, None, :], s_loc + bias.astype(jnp.float32), -jnp.inf)
        s_loc = s_loc.reshape(B, NA_HEADS, n_cb, NA_QBLOCK, n_loc)
        s_ctx = jnp.einsum('bhjqd,bhmd->bhjqm', q_b, kc).astype(jnp.float32) * scale
        p = jax.nn.softmax(jnp.concatenate([s_loc, s_ctx], axis=-1), axis=-1).astype(vx.dtype)
        p_loc = p[..., :n_loc].reshape(B, NA_HEADS, n_cb, NA_QBLOCK, kr, NA_KBAND)
        o = jnp.einsum('bhjqak,bhajke->bhjqe', p_loc, v_r) + jnp.einsum('bhjqm,bhme->bhjqe', p[..., n_loc:], vc)
        return o.reshape(B, NA_HEADS, GRID_W, NA_HEAD_DIM)

    o = lax.map(row_block, jnp.arange(rows))
    ox = o.transpose(1, 0, 3, 2, 4).reshape(B, L, D) @ w_out
    oc = None
    if need_ctx:
        s = jnp.einsum('bhqd,bhkd->bhqk', qc, kc).astype(jnp.float32) * scale
        pc = jax.nn.softmax(s, axis=-1).astype(vc.dtype)
        occ = jnp.einsum('bhqk,bhkd->bhqd', pc, vc)
        oc = occ.transpose(0, 2, 1, 3).reshape(hc.shape[0], hc.shape[1], D) @ w_out
    return ox, oc


def setup_inputs(seed: int = 0) -> dict:
    key = jax.random.key(seed)
    ks = jax.random.split(key, 20)
    D = D_MODEL
    F = FFN_HIDDEN
    GD = POOL_GROUP_DIM

    def nrm(k, shape, s):
        return jax.random.normal(k, shape, jnp.float32) * s

    return {
        'x': nrm(ks[0], (BATCH, SEQ, D), 1.0),
        'c': nrm(ks[1], (BATCH, D), 1.0),
        'ctx': nrm(ks[2], (BATCH, CTX_LEN, D), 1.0),
        'c_ctx': nrm(ks[3], (D,), 1.0),
        'mod_w': nrm(ks[4], (DEPTH, D, N_MOD * D), 0.5 * D ** -0.5),
        'mod_b': nrm(ks[5], (DEPTH, N_MOD * D), 0.02),
        'ln_g': 1.0 + nrm(ks[6], (DEPTH, 2, D), 0.02),
        'ln_b': nrm(ks[7], (DEPTH, 2, D), 0.02),
        'ffn_w_in': nrm(ks[8], (DEPTH, D, 2 * F), D ** -0.5),
        'ffn_w_out': nrm(ks[9], (DEPTH, F, D), BETA * F ** -0.5),
        'pool_w': nrm(ks[10], (N_POOL_LAYERS, N_POOL_GROUPS, GD, GD), BETA * GD ** -0.5),
        'pool_scale': 1.0 + nrm(ks[11], (N_POOL_LAYERS, D), 0.02),
        'hgrn_w_in': nrm(ks[12], (N_HGRN_LAYERS, D, 5 * D), D ** -0.5),
        'hgrn_lb_logits': 1.0 + nrm(ks[13], (2, DEPTH, D), 0.02),
        'hgrn_norm_w': 1.0 + nrm(ks[14], (N_HGRN_LAYERS, D), 0.02),
        'hgrn_w_out': nrm(ks[15], (N_HGRN_LAYERS, D, D), BETA * D ** -0.5),
        'na_w_qkv': nrm(ks[16], (N_NA_LAYERS, D, 3 * D), D ** -0.5),
        'na_rpb': nrm(ks[17], (N_NA_LAYERS, NA_HEADS, 2 * NA_ROWS - 1, 2 * NA_COLS - 1), 0.02),
        'na_w_out': nrm(ks[18], (N_NA_LAYERS, D, D), BETA * D ** -0.5),
    }


def reference(x, c, ctx, c_ctx, mod_w, mod_b, ln_g, ln_b, ffn_w_in, ffn_w_out,
              pool_w, pool_scale, hgrn_w_in, hgrn_lb_logits, hgrn_norm_w, hgrn_w_out,
              na_w_qkv, na_rpb, na_w_out):
    p_lb = jax.nn.softmax(hgrn_lb_logits.astype(jnp.float32), axis=1)
    lower_bounds = jnp.cumsum(p_lb, axis=1) - p_lb[:, :1]
    s_c = jax.nn.silu(c)
    s_cc = jax.nn.silu(c_ctx)
    for i in range(DEPTH):
        last = i == DEPTH - 1
        kind = i % N_MIXERS
        j = i // N_MIXERS
        mod_x = s_c @ mod_w[i] + mod_b[i]
        mod_c = s_cc @ mod_w[i] + mod_b[i]
        sh1, sc1, g1, sh2, sc2, g2 = jnp.split(mod_x[:, None, :], N_MOD, axis=-1)
        csh1, csc1, cg1, csh2, csc2, cg2 = jnp.split(mod_c, N_MOD, axis=-1)
        hx = x * (1.0 + sc1) + sh1
        hc = ctx * (1.0 + csc1) + csh1 if (kind != 0 or not last) else None
        if kind == 0:
            ox, oc = pool_mixer(hx, hc, pool_w[j], pool_scale[j], not last)
        elif kind == 1:
            ox, oc = hgrn2_mixer(hx, hc, hgrn_w_in[j], lower_bounds[0, i], lower_bounds[1, i],
                                 hgrn_norm_w[j], hgrn_w_out[j], not last)
        else:
            ox, oc = na_mixer(hx, hc, na_w_qkv[j], na_rpb[j], na_w_out[j], not last)
        x = layer_norm(ALPHA * x + g1 * ox, ln_g[i, 0], ln_b[i, 0])
        x = layer_norm(ALPHA * x + g2 * swiglu(x * (1.0 + sc2) + sh2, ffn_w_in[i], ffn_w_out[i]),
                       ln_g[i, 1], ln_b[i, 1])
        if not last:
            ctx = layer_norm(ALPHA * ctx + cg1 * oc, ln_g[i, 0], ln_b[i, 0])
            ctx = layer_norm(ALPHA * ctx + cg2 * swiglu(ctx * (1.0 + csc2) + csh2, ffn_w_in[i], ffn_w_out[i]),
                             ln_g[i, 1], ln_b[i, 1])
    return x
```

```cpp
#include <hip/hip_runtime.h>
#include <hip/hip_cooperative_groups.h>
#include <cstdio>
#include <cstdint>
namespace cg = cooperative_groups;

#ifndef MK_MULTI
#define MK_MULTI 0
#endif

#define LAS __attribute__((address_space(3)))
typedef unsigned short bf16_t;
typedef short bf16x8 __attribute__((ext_vector_type(8)));
typedef float f32x4 __attribute__((ext_vector_type(4)));
typedef unsigned u32x4 __attribute__((ext_vector_type(4)));
typedef unsigned u32x2 __attribute__((ext_vector_type(2)));

constexpr int D = 1024, NB = 8, SEQ = 2048, CTXL = 256, TL = NB * SEQ, TC = NB * CTXL, TT = TL + TC, FH = 2816;
constexpr float ALPHA = 1.6817928305074292f;
constexpr float LN_EPS = 1e-6f, RMS_EPS = 1e-6f;
constexpr size_t MiB = 1u << 20;
constexpr size_t WS_MOD = 0;
constexpr size_t WS_LB = 1 * MiB;
constexpr size_t WS_BAR = 1 * MiB + 65536;
constexpr size_t WS_WE = 2 * MiB;
constexpr size_t W_POOL0 = WS_WE;
constexpr size_t W_FI0 = W_POOL0 + 512 * 1024;
constexpr size_t W_FO0 = W_FI0 + 11 * MiB;
constexpr size_t W_HIN = W_FO0 + 11 * MiB / 2;
constexpr size_t W_HOUT = W_HIN + 10 * MiB;
constexpr size_t W_FI1 = W_HOUT + 2 * MiB;
constexpr size_t W_FO1 = W_FI1 + 11 * MiB;
constexpr size_t WS_XC = 48 * MiB;
constexpr size_t WS_HB = 56 * MiB;
constexpr size_t WS_OB = 92 * MiB;
constexpr size_t WS_BIG = 128 * MiB;
constexpr size_t WS_VT = WS_BIG + 144 * MiB;
constexpr size_t WS_VT2 = WS_BIG + 72 * MiB;
constexpr size_t WS_WL = WS_BIG + 120 * MiB;
constexpr size_t W_QKV = WS_WL;
constexpr size_t W_NOUT = W_QKV + 6 * MiB;
constexpr size_t W_FI2 = W_NOUT + 2 * MiB;
constexpr size_t W_FO2 = W_FI2 + 11 * MiB;
constexpr size_t W_POOL1 = W_FO2 + 11 * MiB / 2;
constexpr size_t W_FI3 = W_POOL1 + 512 * 1024;
constexpr size_t W_FO3 = W_FI3 + 11 * MiB;
constexpr size_t WS_END = 308 * MiB;
constexpr int LDS_BYTES = 131072 + 1024;

struct Params {
    const float *x, *c, *ctx, *c_ctx, *mod_w, *mod_b, *ln_g, *ln_b, *ffn_w_in, *ffn_w_out, *pool_w, *pool_scale,
        *hgrn_w_in, *hgrn_lb, *hgrn_norm_w, *hgrn_w_out, *na_w_qkv, *na_rpb, *na_w_out;
    float* out; unsigned char* ws;
};

__device__ __forceinline__ float bf2f(unsigned v) { return __uint_as_float(v << 16); }
typedef __bf16 bf16x2_t __attribute__((ext_vector_type(2)));
__device__ __forceinline__ unsigned cvt_pk_bf16(float lo, float hi) { bf16x2_t v = {(__bf16)lo, (__bf16)hi}; return __builtin_bit_cast(unsigned, v); }
__device__ __forceinline__ bf16_t f2bf(float f) { return (bf16_t)(cvt_pk_bf16(f, 0.f) & 0xffffu); }
__device__ __forceinline__ float silu_f(float x) { return x * __builtin_amdgcn_rcpf(1.f + __expf(-x)); }
__device__ __forceinline__ float wave_sum(float v) {
#pragma unroll
    for (int o = 32; o > 0; o >>= 1) v += __shfl_xor(v, o, 64);
    return v;
}

namespace pg8 {
constexpr int BM = 256, BK = 64, HALF = 128, HTB = HALF * BK * 2, STAGE_BYTES = 8 * HTB, NXCD = 8, WGM = 8;
__host__ __device__ __forceinline__ int lds_byte(int r, int c) { const int st = (r >> 4) * 2 + (c >> 5), rr = r & 15, cc = c & 31, ob = rr * 64 + cc * 2; return st * 1024 + (ob ^ (((ob >> 9) & 1) << 5)); }
__host__ __device__ __forceinline__ void stage_rc(int b, int& R, int& C) { const int st = b / 1024, sb = b % 1024, swz = sb ^ (((sb >> 9) & 1) << 5); R = (st >> 1) * 16 + swz / 64; C = (st & 1) * 32 + (swz % 64) / 2; }
__host__ __device__ __forceinline__ int perm32(int rho) { const int n = rho >> 4, i = rho & 15; return 8 * (i >> 2) + 4 * n + (i & 3); }

struct Unit { const char* a; const char* b; int pm, pn, job; };
struct Sched {
    const char *A0, *B0, *A1, *B1; int nM0, nN0, nM1, nN1, n0, ntot, G, c; unsigned lda_b, ldb_b, acol_pn_b;
    __device__ void init1(const void* A, const void* Bt, int M, int N, unsigned lda, unsigned ldb, unsigned acol, int G_, int c_) {
        A0 = (const char*)A; B0 = (const char*)Bt; A1 = A0; B1 = B0; nM0 = M / BM; nN0 = N / BM; nM1 = 0; nN1 = 1; n0 = nM0 * nN0; ntot = n0; G = G_; c = c_; lda_b = lda; ldb_b = ldb; acol_pn_b = acol; }
    __device__ void add2(const void* A, const void* Bt, int M, int N) { A1 = (const char*)A; B1 = (const char*)Bt; nM1 = M / BM; nN1 = N / BM; ntot = n0 + nM1 * nN1; }
    __device__ bool next(int i, Unit& u) const {
        const long L = (long)i * G + c; if (L >= ntot) return false;
        const int job = L >= n0; int wgid = (int)L - (job ? n0 : 0);
        const int nM = job ? nM1 : nM0, nN = job ? nN1 : nN0, nwg = nM * nN;
        { const int q = nwg / NXCD, r = nwg % NXCD, xcd = wgid % NXCD, off = wgid / NXCD; wgid = (xcd < r ? xcd * (q + 1) : r * (q + 1) + (xcd - r) * q) + off; }
        const int nig = WGM * nN, gid = wgid / nig, fm = gid * WGM, gsz = (nM - fm) < WGM ? (nM - fm) : WGM;
        u.pm = fm + ((wgid % nig) % gsz); u.pn = (wgid % nig) / gsz; u.job = job;
        u.a = (job ? A1 : A0) + (size_t)u.pm * BM * lda_b + (size_t)u.pn * acol_pn_b; u.b = (job ? B1 : B0) + (size_t)u.pn * BM * ldb_b; return true;
    }
};

struct EpiBf16P {
    static constexpr bool PERM = true;
    bf16_t* O0; bf16_t* O1; int ldc0, ldc1; const float* lbp; int hg;
    __device__ __forceinline__ void operator()(const f32x4 (&acc)[2][2][4][2], const Unit& u, int wr, int wc, int fr, int fq) const {
        bf16_t* base = u.job ? O1 : O0; const int ldc = u.job ? ldc1 : ldc0;
        const int row0 = u.pm * BM + wr * 64 + fr, col0 = u.pn * BM + wc * 32 + 8 * fq;
        const int kind = (!hg || u.job) ? 0 : ((u.pn >= 4 && u.pn < 12) ? 2 : 1);
        f32x4 lb[2][2];
        if (kind == 2) { const float* lp = lbp + (col0 - 1024);
#pragma unroll
            for (int bj = 0; bj < 2; ++bj) { lb[bj][0] = *(const f32x4*)(lp + bj * HALF); lb[bj][1] = *(const f32x4*)(lp + bj * HALF + 4); } }
#pragma unroll
        for (int ai = 0; ai < 2; ++ai)
#pragma unroll
            for (int m = 0; m < 4; ++m) { bf16_t* rowp = base + (size_t)(row0 + ai * HALF + m * 16) * ldc + col0;
#pragma unroll
                for (int bj = 0; bj < 2; ++bj) { f32x4 v0 = acc[ai][bj][m][0], v1 = acc[ai][bj][m][1];
                    if (kind == 1) {
#pragma unroll
                        for (int j = 0; j < 4; ++j) { v0[j] = silu_f(v0[j]); v1[j] = silu_f(v1[j]); } }
                    else if (kind == 2) {
#pragma unroll
                        for (int j = 0; j < 4; ++j) { const float s0 = __builtin_amdgcn_rcpf(1.f + __expf(-v0[j])), s1 = __builtin_amdgcn_rcpf(1.f + __expf(-v1[j]));
                            v0[j] = __log2f(lb[bj][0][j] + (1.f - lb[bj][0][j]) * s0); v1[j] = __log2f(lb[bj][1][j] + (1.f - lb[bj][1][j]) * s1); } }
                    u32x4 w; w.x = cvt_pk_bf16(v0[0], v0[1]); w.y = cvt_pk_bf16(v0[2], v0[3]); w.z = cvt_pk_bf16(v1[0], v1[1]); w.w = cvt_pk_bf16(v1[2], v1[3]);
                    *(u32x4*)(rowp + bj * HALF) = w; } }
    }
};
struct EpiSwiGLU {
    static constexpr bool PERM = true;
    bf16_t* U;
    __device__ __forceinline__ void operator()(const f32x4 (&acc)[2][2][4][2], const Unit& u, int wr, int wc, int fr, int fq) const {
        const int row0 = u.pm * BM + wr * 64 + fr, col0 = u.pn * HALF + wc * 32 + 8 * fq;
#pragma unroll
        for (int ai = 0; ai < 2; ++ai)
#pragma unroll
            for (int m = 0; m < 4; ++m) { bf16_t* rowp = U + (size_t)(row0 + ai * HALF + m * 16) * FH + col0;
                float r[8];
#pragma unroll
                for (int n = 0; n < 2; ++n)
#pragma unroll
                    for (int j = 0; j < 4; ++j) { const float g = acc[ai][0][m][n][j], up = acc[ai][1][m][n][j]; r[n * 4 + j] = silu_f(g) * up; }
                u32x4 w; w.x = cvt_pk_bf16(r[0], r[1]); w.y = cvt_pk_bf16(r[2], r[3]); w.z = cvt_pk_bf16(r[4], r[5]); w.w = cvt_pk_bf16(r[6], r[7]);
                *(u32x4*)rowp = w; }
    }
};
struct EpiResid {
    static constexpr bool PERM = false;
    const float* srcL; const float* srcC; float* dstL; float* dstC; const float* gate; const float* scale;
    __device__ __forceinline__ void operator()(const f32x4 (&acc)[2][2][4][2], const Unit& u, int wr, int wc, int fr, int fq) const {
        const int row0 = u.pm * BM + wr * 64 + fr, col0 = u.pn * BM + wc * 32 + 4 * fq;
        const bool lat = row0 < TL;
#pragma unroll
        for (int ai = 0; ai < 2; ++ai)
#pragma unroll
            for (int m = 0; m < 4; ++m) { const int row = row0 + ai * HALF + m * 16; const int mr = lat ? (row >> 11) : 8;
                const float* sp = lat ? srcL + (size_t)row * D : srcC + (size_t)(row - TL) * D; float* dp = lat ? dstL + (size_t)row * D : dstC + (size_t)(row - TL) * D;
                const float* gp = gate + mr * 6144;
#pragma unroll
                for (int bj = 0; bj < 2; ++bj)
#pragma unroll
                    for (int n = 0; n < 2; ++n) { const int col = col0 + bj * HALF + n * 16; f32x4 a = acc[ai][bj][m][n];
                        if (scale) a = a * *(const f32x4*)(scale + col);
                        const f32x4 xv = *(const f32x4*)(sp + col), gv = *(const f32x4*)(gp + col);
                        *(f32x4*)(dp + col) = xv * ALPHA + gv * a; } }
    }
};

template <class Epi>
__device__ __forceinline__ void gemm_phase(LAS unsigned char* lds, const int K, const Sched& S, const Epi& E, const int TID, const int BID, const int GRD) {
    const int tid = TID, wid = __builtin_amdgcn_readfirstlane(tid >> 6), lane = tid & 63, wr = wid >> 2, wc = wid & 3, fr = lane & 15, fq = lane >> 4;
    const int nt = K / BK;
    unsigned voffA[2], voffB[2];
#pragma unroll
    for (int i = 0; i < 2; ++i) { int R, C; stage_rc(tid * 16 + i * 8192, R, C); const int Rb = Epi::PERM ? ((R & ~31) + perm32(R & 31)) : R;
        voffA[i] = (unsigned)R * S.lda_b + (unsigned)C * 2u; voffB[i] = (unsigned)Rb * S.ldb_b + (unsigned)C * 2u; }
    const size_t kstep = (size_t)(BK * 2);
    const size_t hsA = (size_t)HALF * S.lda_b, hsB = (size_t)HALF * S.ldb_b;
    const unsigned ldsw = (unsigned)wid * 1024u;
    const int aoff = lds_byte(wr * 64 + fr, fq * 8), boff = lds_byte(wc * 32 + fr, fq * 8);
#define PG8_SA(b, h) (((b) * 2 + (h)) * HTB)
#define PG8_SB(b, h) ((4 + (b) * 2 + (h)) * HTB)
#define PG8_STAGE(bufoff, gbase, voff) do { _Pragma("unroll") for (int _i = 0; _i < 2; ++_i) \
        __builtin_amdgcn_global_load_lds((const unsigned*)((const char*)(gbase) + (voff)[_i]), (LAS unsigned*)(lds + (bufoff) + ldsw + _i * 8192), 16, 0, 0); } while (0)
#define PG8_LDA(dst, b, h) do { _Pragma("unroll") for (int m = 0; m < 4; ++m) _Pragma("unroll") for (int k = 0; k < 2; ++k) dst[m][k] = *(const LAS bf16x8*)(lds + PG8_SA(b, h) + aoff + m * 2048 + k * 1024); } while (0)
#define PG8_LDB(dst, b, h) do { _Pragma("unroll") for (int n = 0; n < 2; ++n) _Pragma("unroll") for (int k = 0; k < 2; ++k) dst[n][k] = *(const LAS bf16x8*)(lds + PG8_SB(b, h) + boff + n * 2048 + k * 1024); } while (0)
#define PG8_MMA(ai, bj, At, Bt) do { __builtin_amdgcn_s_setprio(1); _Pragma("unroll") for (int m = 0; m < 4; ++m) _Pragma("unroll") for (int n = 0; n < 2; ++n) _Pragma("unroll") for (int k = 0; k < 2; ++k) \
        acc[ai][bj][m][n] = __builtin_amdgcn_mfma_f32_16x16x32_bf16(Bt[n][k], At[m][k], acc[ai][bj][m][n], 0, 0, 0); __builtin_amdgcn_s_setprio(0); } while (0)
#define PG8_WAIT_V(n) asm volatile("s_waitcnt vmcnt(" #n ")" ::: "memory")
#define PG8_WAIT_L(n) asm volatile("s_waitcnt lgkmcnt(" #n ")" ::: "memory")
#define PG8_BAR __builtin_amdgcn_s_barrier()
#define PG8_SCHED __builtin_amdgcn_sched_barrier(0)
    Unit cur, nxt; int ui = 0;
    if (!S.next(0, cur)) return;
    f32x4 acc[2][2][4][2];
#pragma unroll
    for (int a = 0; a < 2; ++a)
#pragma unroll
        for (int b = 0; b < 2; ++b)
#pragma unroll
            for (int m = 0; m < 4; ++m)
#pragma unroll
                for (int n = 0; n < 2; ++n) acc[a][b][m][n] = (f32x4){0.f, 0.f, 0.f, 0.f};
    bf16x8 At[4][2], B0[2][2], B1[2][2];
    const char* cA = cur.a; const char* cB = cur.b;
    PG8_STAGE(PG8_SB(0, 0), cB, voffB); PG8_STAGE(PG8_SB(0, 1), cB + hsB, voffB); PG8_STAGE(PG8_SA(0, 0), cA, voffA); PG8_STAGE(PG8_SA(0, 1), cA + hsA, voffA);
    if (wr == 1) PG8_BAR;
    PG8_WAIT_V(2); PG8_BAR;
    PG8_STAGE(PG8_SB(1, 0), cB + kstep, voffB); PG8_STAGE(PG8_SA(1, 0), cA + kstep, voffA); PG8_STAGE(PG8_SB(1, 1), cB + hsB + kstep, voffB);
    PG8_WAIT_V(6); PG8_BAR;
    for (;;) {
        const bool has_next = S.next(ui + 1, nxt);
        const char* nA = has_next ? nxt.a : cA; const char* nB = has_next ? nxt.b : cB;
        for (int t = 0; t < nt; t += 2) {
            const bool last = (t == nt - 2);
            const char* a1 = cA + (size_t)(t + 1) * kstep;
            const char* a2 = last ? nA : cA + (size_t)(t + 2) * kstep; const char* b2 = last ? nB : cB + (size_t)(t + 2) * kstep;
            const char* a3 = a2 + kstep; const char* b3 = b2 + kstep;
            PG8_LDB(B0, 0, 0); PG8_LDB(B1, 0, 1); PG8_SCHED; PG8_LDA(At, 0, 0); PG8_STAGE(PG8_SA(1, 1), a1 + hsA, voffA);
            PG8_WAIT_V(8); PG8_WAIT_L(0); PG8_BAR; PG8_MMA(0, 0, At, B0); PG8_MMA(0, 1, At, B1); PG8_BAR; PG8_SCHED;
            PG8_LDA(At, 0, 1); PG8_STAGE(PG8_SB(0, 0), b2, voffB); PG8_STAGE(PG8_SB(0, 1), b2 + hsB, voffB); PG8_STAGE(PG8_SA(0, 0), a2, voffA);
            PG8_WAIT_V(8); PG8_WAIT_L(0); PG8_BAR; PG8_MMA(1, 0, At, B0); PG8_MMA(1, 1, At, B1); PG8_BAR; PG8_SCHED;
            PG8_LDB(B0, 1, 0); PG8_LDB(B1, 1, 1); PG8_SCHED; PG8_LDA(At, 1, 0); PG8_STAGE(PG8_SA(0, 1), a2 + hsA, voffA);
            PG8_WAIT_V(8); PG8_WAIT_L(0); PG8_BAR; PG8_MMA(0, 0, At, B0); PG8_MMA(0, 1, At, B1); PG8_BAR; PG8_SCHED;
            PG8_LDA(At, 1, 1); PG8_STAGE(PG8_SB(1, 0), b3, voffB); PG8_STAGE(PG8_SB(1, 1), b3 + hsB, voffB); PG8_STAGE(PG8_SA(1, 0), a3, voffA);
            PG8_WAIT_V(8); PG8_WAIT_L(0); PG8_BAR; PG8_MMA(1, 0, At, B0); PG8_MMA(1, 1, At, B1); PG8_BAR; PG8_SCHED;
        }
        if (wr == 0) PG8_BAR;
        E(acc, cur, wr, wc, fr, fq);
        if (!has_next) break;
#pragma unroll
        for (int a = 0; a < 2; ++a)
#pragma unroll
            for (int b = 0; b < 2; ++b)
#pragma unroll
                for (int m = 0; m < 4; ++m)
#pragma unroll
                    for (int n = 0; n < 2; ++n) acc[a][b][m][n] = (f32x4){0.f, 0.f, 0.f, 0.f};
        cur = nxt; cA = nA; cB = nB; ++ui;
        if (wr == 1) PG8_BAR;
    }
    PG8_WAIT_V(0);
    PG8_BAR;
#undef PG8_SA
#undef PG8_SB
#undef PG8_STAGE
#undef PG8_LDA
#undef PG8_LDB
#undef PG8_MMA
#undef PG8_WAIT_V
#undef PG8_WAIT_L
#undef PG8_BAR
#undef PG8_SCHED
}
}

__device__ __forceinline__ int map_row(int n, int mode) {
    if (mode == 1) { const int up = n >= FH; const int hh = up ? n - FH : n; return (hh >> 7) * 256 + up * 128 + (hh & 127); }
    if (mode == 2) { return n < 1024 ? n : (n < 2048 ? 4096 + (n - 1024) : n - 1024); }
    return n;
}
struct ConvJob { const float* src; bf16_t* dst; int K, N, mode; };
__device__ __forceinline__ void get_conv_job(const Params& p, int j, ConvJob& c) {
    unsigned char* ws = p.ws;
    c.mode = 0;
    if (j < 4) { c.src = p.pool_w + (size_t)j * 65536; c.dst = (bf16_t*)(ws + W_POOL0) + (size_t)j * 65536; c.K = 256; c.N = 256; }
    else if (j == 4) { c.src = p.ffn_w_in; c.dst = (bf16_t*)(ws + W_FI0); c.K = 1024; c.N = 5632; c.mode = 1; }
    else if (j == 5) { c.src = p.ffn_w_out; c.dst = (bf16_t*)(ws + W_FO0); c.K = 2816; c.N = 1024; }
    else if (j == 6) { c.src = p.hgrn_w_in; c.dst = (bf16_t*)(ws + W_HIN); c.K = 1024; c.N = 5120; c.mode = 2; }
    else if (j == 7) { c.src = p.hgrn_w_out; c.dst = (bf16_t*)(ws + W_HOUT); c.K = 1024; c.N = 1024; }
    else if (j == 8) { c.src = p.ffn_w_in + (size_t)1 * 1024 * 5632; c.dst = (bf16_t*)(ws + W_FI1); c.K = 1024; c.N = 5632; c.mode = 1; }
    else if (j == 9) { c.src = p.ffn_w_out + (size_t)1 * 2816 * 1024; c.dst = (bf16_t*)(ws + W_FO1); c.K = 2816; c.N = 1024; }
    else if (j == 10) { c.src = p.na_w_qkv; c.dst = (bf16_t*)(ws + W_QKV); c.K = 1024; c.N = 3072; }
    else if (j == 11) { c.src = p.na_w_out; c.dst = (bf16_t*)(ws + W_NOUT); c.K = 1024; c.N = 1024; }
    else if (j == 12) { c.src = p.ffn_w_in + (size_t)2 * 1024 * 5632; c.dst = (bf16_t*)(ws + W_FI2); c.K = 1024; c.N = 5632; c.mode = 1; }
    else if (j == 13) { c.src = p.ffn_w_out + (size_t)2 * 2816 * 1024; c.dst = (bf16_t*)(ws + W_FO2); c.K = 2816; c.N = 1024; }
    else if (j < 18) { const int g = j - 14; c.src = p.pool_w + 262144 + (size_t)g * 65536; c.dst = (bf16_t*)(ws + W_POOL1) + (size_t)g * 65536; c.K = 256; c.N = 256; }
    else if (j == 18) { c.src = p.ffn_w_in + (size_t)3 * 1024 * 5632; c.dst = (bf16_t*)(ws + W_FI3); c.K = 1024; c.N = 5632; c.mode = 1; }
    else { c.src = p.ffn_w_out + (size_t)3 * 2816 * 1024; c.dst = (bf16_t*)(ws + W_FO3); c.K = 2816; c.N = 1024; }
}
__device__ __forceinline__ bool conv_locate(const Params& p, int j0, int j1, int g, ConvJob& c, int& t) {
    for (int j = j0; j < j1; ++j) { get_conv_job(p, j, c); const int nt = (c.K >> 6) * (c.N >> 7); if (g < nt) { t = g; return true; } g -= nt; }
    return false;
}
__device__ __forceinline__ void conv_load(const ConvJob& c, int tile, f32x4 (&v)[4], const int TID) {
    const int ntn = c.N >> 7; const int k0 = (tile / ntn) * 64, n0 = (tile % ntn) * 128;
#pragma unroll
    for (int it = 0; it < 4; ++it) { const int idx = TID + it * 512; const int kk = idx >> 5, n4 = idx & 31;
        v[it] = *(const f32x4*)(c.src + (size_t)(k0 + kk) * c.N + n0 + n4 * 4); }
}
__device__ void conv_jobs(const Params& p, int j0, int j1, LAS unsigned char* ldsb, const int TID, const int BIDe, const int GRDe) {
    LAS float* lds = (LAS float*)ldsb;
    ConvJob c, cn; int t = 0, tn = 0; f32x4 v[4], vn[4];
    int g = BIDe;
    bool have = conv_locate(p, j0, j1, g, c, t);
    if (have) conv_load(c, t, v, TID);
    while (have) {
        const bool hn = conv_locate(p, j0, j1, g + GRDe, cn, tn);
        if (hn) conv_load(cn, tn, vn, TID);
        const int ntn = c.N >> 7; const int k0 = (t / ntn) * 64, n0 = (t % ntn) * 128;
#pragma unroll
        for (int it = 0; it < 4; ++it) { const int idx = TID + it * 512; const int kk = idx >> 5, n4 = idx & 31; *(LAS f32x4*)(lds + kk * 132 + n4 * 4) = v[it]; }
        __syncthreads();
#pragma unroll
        for (int it = 0; it < 2; ++it) { const int idx = TID + it * 512; const int n = idx & 127, kg = idx >> 7;
            float x[8];
#pragma unroll
            for (int i = 0; i < 8; ++i) x[i] = lds[(kg * 8 + i) * 132 + n];
            u32x4 w; w.x = cvt_pk_bf16(x[0], x[1]); w.y = cvt_pk_bf16(x[2], x[3]); w.z = cvt_pk_bf16(x[4], x[5]); w.w = cvt_pk_bf16(x[6], x[7]);
            const int row = map_row(n0 + n, c.mode);
            *(u32x4*)(c.dst + (size_t)row * c.K + k0 + kg * 8) = w; }
        __syncthreads();
        g += GRDe; have = hn; c = cn; t = tn;
#pragma unroll
        for (int it = 0; it < 4; ++it) v[it] = vn[it];
    }
}
__device__ void mod_gemv(const Params& p, LAS unsigned char* lds, int l0, int l1, const int TID, const int BIDe, const int GRDe) {
    LAS float* s = (LAS float*)lds;
    LAS float* red = (LAS float*)(lds + 9 * 1024 * 4);
    const int tid = TID; const int nitems = (l1 - l0) * 96;
    if (BIDe >= nitems) return;
    for (int i = tid; i < 9 * 1024; i += 512) { const int j = i >> 10, k = i & 1023; const float v = j < 8 ? p.c[j * 1024 + k] : p.c_ctx[k]; s[i] = silu_f(v); }
    __syncthreads();
    float* MOD = (float*)(p.ws + WS_MOD);
    for (int item = BIDe; item < nitems; item += GRDe) {
        const int l = l0 + item / 96, n0 = (item % 96) * 64; const int pp = tid >> 4, c4 = (tid & 15) * 4;
        f32x4 acc[9];
#pragma unroll
        for (int j = 0; j < 9; ++j) acc[j] = (f32x4){0.f, 0.f, 0.f, 0.f};
        const float* w = p.mod_w + (size_t)l * 1024 * 6144 + n0 + c4;
#pragma unroll 8
        for (int k = pp * 32; k < pp * 32 + 32; ++k) { const f32x4 wv = *(const f32x4*)(w + (size_t)k * 6144);
#pragma unroll
            for (int j = 0; j < 9; ++j) acc[j] = acc[j] + wv * s[j * 1024 + k]; }
#pragma unroll
        for (int j = 0; j < 9; ++j) *(LAS f32x4*)(red + (pp * 9 + j) * 64 + c4) = acc[j];
        __syncthreads();
        for (int o = tid; o < 9 * 64; o += 512) { const int j = o >> 6, col = o & 63; float v = p.mod_b[l * 6144 + n0 + col];
#pragma unroll 8
            for (int q = 0; q < 32; ++q) v += red[(q * 9 + j) * 64 + col];
            MOD[(size_t)(l * 9 + j) * 6144 + n0 + col] = v; }
        __syncthreads();
    }
}
__device__ void lb_compute(const Params& p, const int TID, const int BID, const int GRD) {
    float* LB = (float*)(p.ws + WS_LB);
    for (int i = BID * 512 + TID; i < 2048; i += GRD * 512) { const int dir = i >> 10, cidx = i & 1023;
        float l[4], mx = -1e30f;
#pragma unroll
        for (int j = 0; j < 4; ++j) { l[j] = p.hgrn_lb[(dir * 4 + j) * 1024 + cidx]; mx = fmaxf(mx, l[j]); }
        float sum = 0.f, e1 = 0.f;
#pragma unroll
        for (int j = 0; j < 4; ++j) { const float e = __expf(l[j] - mx); sum += e; if (j == 1) e1 = e; }
        LB[i] = e1 / sum; }
}

__device__ void ln_pass(float* xl, float* xc, int rows, const float* g, const float* bta, const float* modsc, const float* modsh, bf16_t* hb, const int TID, const int BID, const int GRD) {
    const int wave = TID >> 6, lane = TID & 63;
    const int stride = GRD * 8;
    for (int row0 = BID * 8 + wave; row0 < rows; row0 += 2 * stride) {
        const int row1 = row0 + stride; const bool has1 = row1 < rows;
        float* xp0 = row0 < TL ? xl + (size_t)row0 * D : xc + (size_t)(row0 - TL) * D;
        float* xp1 = has1 ? (row1 < TL ? xl + (size_t)row1 * D : xc + (size_t)(row1 - TL) * D) : xp0;
        f32x4 v0[4], v1[4]; float s0 = 0.f, s1 = 0.f;
#pragma unroll
        for (int i = 0; i < 4; ++i) { v0[i] = *(const f32x4*)(xp0 + lane * 4 + i * 256); v1[i] = *(const f32x4*)(xp1 + lane * 4 + i * 256); }
#pragma unroll
        for (int i = 0; i < 4; ++i) { s0 += v0[i][0] + v0[i][1] + v0[i][2] + v0[i][3]; s1 += v1[i][0] + v1[i][1] + v1[i][2] + v1[i][3]; }
        const float mean0 = wave_sum(s0) * (1.f / 1024.f), mean1 = wave_sum(s1) * (1.f / 1024.f);
        float q0 = 0.f, q1 = 0.f;
#pragma unroll
        for (int i = 0; i < 4; ++i) { v0[i] = v0[i] - mean0; v1[i] = v1[i] - mean1;
            q0 += v0[i][0] * v0[i][0] + v0[i][1] * v0[i][1] + v0[i][2] * v0[i][2] + v0[i][3] * v0[i][3];
            q1 += v1[i][0] * v1[i][0] + v1[i][1] * v1[i][1] + v1[i][2] * v1[i][2] + v1[i][3] * v1[i][3]; }
        const float rstd0 = rsqrtf(wave_sum(q0) * (1.f / 1024.f) + LN_EPS), rstd1 = rsqrtf(wave_sum(q1) * (1.f / 1024.f) + LN_EPS);
        const int mr0 = row0 < TL ? (row0 >> 11) : 8, mr1 = row1 < TL ? (row1 >> 11) : 8;
#pragma unroll
        for (int i = 0; i < 4; ++i) { const int c = lane * 4 + i * 256;
            const f32x4 gv = *(const f32x4*)(g + c), bv = *(const f32x4*)(bta + c);
            const f32x4 y0 = v0[i] * rstd0 * gv + bv, y1 = v1[i] * rstd1 * gv + bv;
            *(f32x4*)(xp0 + c) = y0;
            if (has1) *(f32x4*)(xp1 + c) = y1;
            if (hb) { const f32x4 sc0 = *(const f32x4*)(modsc + mr0 * 6144 + c), sh0 = *(const f32x4*)(modsh + mr0 * 6144 + c);
                const f32x4 h0 = y0 * (sc0 + 1.f) + sh0; u32x2 w; w.x = cvt_pk_bf16(h0[0], h0[1]); w.y = cvt_pk_bf16(h0[2], h0[3]);
                *(u32x2*)(hb + (size_t)row0 * D + c) = w;
                if (has1) { const f32x4 sc1 = *(const f32x4*)(modsc + mr1 * 6144 + c), sh1 = *(const f32x4*)(modsh + mr1 * 6144 + c);
                    const f32x4 h1 = y1 * (sc1 + 1.f) + sh1; u32x2 w1; w1.x = cvt_pk_bf16(h1[0], h1[1]); w1.y = cvt_pk_bf16(h1[2], h1[3]);
                    *(u32x2*)(hb + (size_t)row1 * D + c) = w1; } } }
    }
}
__device__ void pool_prep(const float* srcL, const float* srcC, int rows, const float* modsc, bf16_t* out, const int TID, const int BID, const int GRD) {
    const int nitems = (rows >> 5) * 256;
    for (int it = BID * 512 + TID; it < nitems; it += GRD * 512) {
        const int run = it >> 8, c = (it & 255) * 4; const int g = c >> 8; const int w = 2 << g, lo = w >> 1, hi = w - 1 - lo;
        const int row0 = run * 32; const bool lat = row0 < TL; const int t0 = lat ? (row0 & 2047) : ((row0 - TL) & 255); const int L = lat ? SEQ : CTXL;
        const float* base = (lat ? srcL + (size_t)(row0 - t0) * D : srcC + (size_t)(row0 - TL - t0) * D) + c;
        const int mr = lat ? (row0 >> 11) : 8;
        const f32x4 sc1 = *(const f32x4*)(modsc + mr * 6144 + c) + 1.f;
        f32x4 acc = {0.f, 0.f, 0.f, 0.f};
        int s0 = t0 - lo < 0 ? 0 : t0 - lo, e0 = t0 + hi + 1 > L ? L : t0 + hi + 1;
        for (int tt = s0; tt < e0; ++tt) acc = acc + *(const f32x4*)(base + (size_t)tt * D);
        bf16_t* op = out + (size_t)row0 * D + c;
#pragma unroll 4
        for (int i = 0; i < 32; ++i) { const int t = t0 + i;
            const f32x4 xv = *(const f32x4*)(base + (size_t)t * D);
            const float inv = 1.f / (float)(e0 - s0);
            const f32x4 r = (acc * inv - xv) * sc1;
            u32x2 wv; wv.x = cvt_pk_bf16(r[0], r[1]); wv.y = cvt_pk_bf16(r[2], r[3]);
            *(u32x2*)(op + (size_t)i * D) = wv;
            if (t + 1 + hi < L) { acc = acc + *(const f32x4*)(base + (size_t)(t + 1 + hi) * D); ++e0; }
            if (t + 1 - lo > 0) { acc = acc - *(const f32x4*)(base + (size_t)(t - lo) * D); ++s0; } }
    }
}

__device__ void scan_phase(const Params& p, LAS unsigned char* lds, const int TID, const int BID, const int GRD) {
    constexpr int QP = 0, KP = 17408, KPT = 34816, VTO = 53248, AM = 62464, STO = 71680, GS = 89088, DEC = 91136;
    const bf16_t* P = (const bf16_t*)(p.ws + WS_BIG); const bf16_t* VTg = (const bf16_t*)(p.ws + WS_VT);
    const int tid = TID, wave = tid >> 6, lane = tid & 63, l15 = lane & 15, quad = lane >> 4;
    LAS float* gs = (LAS float*)(lds + GS); LAS float* dec = (LAS float*)(lds + DEC);
    for (int task = BID; task < 256; task += GRD) {
        const int eh = task & 1, dir = (task >> 1) & 1, h = (task >> 2) & 7, b = task >> 5;
        bf16_t* Og = (bf16_t*)(p.ws + (dir ? WS_OB : WS_HB));
        const int d = tid & 127, tg = tid >> 7;
        const int zoff = (dir ? 2048 : 1024) + h * 128 + d, qoff = h * 128 + d;
        f32x4 Sacc[4];
#pragma unroll
        for (int i = 0; i < 4; ++i) Sacc[i] = (f32x4){0.f, 0.f, 0.f, 0.f};
#define SCAN_ROW0(st_) ((st_) < 4 ? TL + b * CTXL + (dir ? 3 - (st_) : (st_)) * 64 : b * SEQ + (dir ? 31 - ((st_) - 4) : (st_) - 4) * 64)
#define SCAN_LOAD(st_) do { const int r0_ = SCAN_ROW0(st_); const bf16_t* Pr_ = P + (size_t)(r0_ + tg * 16) * 4096; \
            _Pragma("unroll") for (int i = 0; i < 16; ++i) { zr[i] = Pr_[(size_t)i * 4096 + zoff]; qr[i] = Pr_[(size_t)i * 4096 + qoff]; } \
            vtr = *(const u32x4*)(VTg + (size_t)(h * 128 + eh * 64 + (tid >> 3)) * TT + r0_ + (tid & 7) * 8); } while (0)
        bf16_t zr[16], qr[16]; u32x4 vtr;
        SCAN_LOAD(0);
        for (int step = 0; step < 36; ++step) {
            const int row0 = SCAN_ROW0(step);
            float lf[16], kk[16], qv[16];
#pragma unroll
            for (int i = 0; i < 16; ++i) { lf[i] = bf2f(zr[i]); kk[i] = 1.f - __builtin_amdgcn_exp2f(lf[i]); qv[i] = bf2f(qr[i]); }
            { const int e = tid >> 3, s8 = tid & 7; *(LAS u32x4*)(lds + VTO + e * 144 + s8 * 16) = vtr; }
            if (step + 1 < 36) SCAN_LOAD(step + 1);
            float run = 0.f;
            if (dir == 0) {
#pragma unroll
                for (int i = 0; i < 16; ++i) { run += lf[i]; lf[i] = run; }
            } else {
#pragma unroll
                for (int i = 15; i >= 0; --i) { run += lf[i]; lf[i] = run; }
            }
            gs[tg * 128 + d] = run;
            __syncthreads();
            const float g0 = gs[d], g1 = gs[128 + d], g2 = gs[256 + d], g3 = gs[384 + d];
            const float tot = g0 + g1 + g2 + g3;
            float off, cref;
            if (dir == 0) { off = (tg > 0 ? g0 : 0.f) + (tg > 1 ? g1 : 0.f) + (tg > 2 ? g2 : 0.f); cref = g0 + g1; }
            else { off = (tg < 3 ? g3 : 0.f) + (tg < 2 ? g2 : 0.f) + (tg < 1 ? g1 : 0.f); cref = g3 + g2; }
            if (tg == 0) { dec[d] = __builtin_amdgcn_exp2f(tot); dec[128 + d] = __builtin_amdgcn_exp2f(tot - cref); dec[256 + d] = __builtin_amdgcn_exp2f(cref); }
            unsigned kp[8];
#pragma unroll
            for (int i = 0; i < 16; i += 2) {
                const float b0 = off + lf[i] - cref, b1 = off + lf[i + 1] - cref;
                const float q0 = qv[i] * __builtin_amdgcn_exp2f(b0), q1 = qv[i + 1] * __builtin_amdgcn_exp2f(b1), k0 = kk[i] * __builtin_amdgcn_exp2f(-b0), k1 = kk[i + 1] * __builtin_amdgcn_exp2f(-b1);
                const int t0 = tg * 16 + i;
                *(LAS bf16_t*)(lds + QP + t0 * 272 + d * 2) = f2bf(q0); *(LAS bf16_t*)(lds + QP + (t0 + 1) * 272 + d * 2) = f2bf(q1);
                const unsigned kpk = cvt_pk_bf16(k0, k1); kp[i >> 1] = kpk;
                *(LAS bf16_t*)(lds + KP + t0 * 272 + d * 2) = (bf16_t)(kpk & 0xffffu); *(LAS bf16_t*)(lds + KP + (t0 + 1) * 272 + d * 2) = (bf16_t)(kpk >> 16); }
            *(LAS u32x4*)(lds + KPT + d * 144 + tg * 32) = (u32x4){kp[0], kp[1], kp[2], kp[3]};
            *(LAS u32x4*)(lds + KPT + d * 144 + tg * 32 + 16) = (u32x4){kp[4], kp[5], kp[6], kp[7]};
            __syncthreads();
            { const int dd = wave * 16 + l15; const float dm = dec[256 + dd];
#pragma unroll
              for (int em = 0; em < 4; ++em)
#pragma unroll
                  for (int j = 0; j < 4; ++j) *(LAS bf16_t*)(lds + STO + (em * 16 + quad * 4 + j) * 272 + dd * 2) = f2bf(Sacc[em][j] * dm); }
            const int tm = wave >> 1;
#pragma unroll
            for (int u = 0; u < 2; ++u) { const int sn = (wave & 1) * 2 + u; f32x4 a = {0.f, 0.f, 0.f, 0.f};
#pragma unroll
                for (int k4 = 0; k4 < 4; ++k4) { const bf16x8 af = *(const LAS bf16x8*)(lds + QP + (tm * 16 + l15) * 272 + k4 * 64 + quad * 16);
                    const bf16x8 bfr = *(const LAS bf16x8*)(lds + KP + (sn * 16 + l15) * 272 + k4 * 64 + quad * 16);
                    a = __builtin_amdgcn_mfma_f32_16x16x32_bf16(af, bfr, a, 0, 0, 0); }
#pragma unroll
                for (int j = 0; j < 4; ++j) { const int t = tm * 16 + quad * 4 + j, s = sn * 16 + l15; const bool keep = dir ? (s >= t) : (s <= t);
                    *(LAS bf16_t*)(lds + AM + t * 144 + s * 2) = f2bf(keep ? a[j] : 0.f); } }
            __syncthreads();
#pragma unroll
            for (int u = 0; u < 2; ++u) { const int en = (wave & 1) * 2 + u; f32x4 o = {0.f, 0.f, 0.f, 0.f};
#pragma unroll
                for (int k2 = 0; k2 < 2; ++k2) { const bf16x8 af = *(const LAS bf16x8*)(lds + AM + (tm * 16 + l15) * 144 + k2 * 64 + quad * 16);
                    const bf16x8 bfr = *(const LAS bf16x8*)(lds + VTO + (en * 16 + l15) * 144 + k2 * 64 + quad * 16);
                    o = __builtin_amdgcn_mfma_f32_16x16x32_bf16(af, bfr, o, 0, 0, 0); }
#pragma unroll
                for (int k4 = 0; k4 < 4; ++k4) { const bf16x8 af = *(const LAS bf16x8*)(lds + QP + (tm * 16 + l15) * 272 + k4 * 64 + quad * 16);
                    const bf16x8 bfr = *(const LAS bf16x8*)(lds + STO + (en * 16 + l15) * 272 + k4 * 64 + quad * 16);
                    o = __builtin_amdgcn_mfma_f32_16x16x32_bf16(af, bfr, o, 0, 0, 0); }
#pragma unroll
                for (int j = 0; j < 4; ++j) { const int t = tm * 16 + quad * 4 + j, e = en * 16 + l15;
                    Og[(size_t)(row0 + t) * D + h * 128 + eh * 64 + e] = f2bf(o[j]); } }
            { const int dd = wave * 16 + l15; const float de = dec[dd], dk = dec[128 + dd];
#pragma unroll
              for (int em = 0; em < 4; ++em) { f32x4 kv = {0.f, 0.f, 0.f, 0.f};
#pragma unroll
                  for (int k2 = 0; k2 < 2; ++k2) { const bf16x8 af = *(const LAS bf16x8*)(lds + VTO + (em * 16 + l15) * 144 + k2 * 64 + quad * 16);
                      const bf16x8 bfr = *(const LAS bf16x8*)(lds + KPT + (wave * 16 + l15) * 144 + k2 * 64 + quad * 16);
                      kv = __builtin_amdgcn_mfma_f32_16x16x32_bf16(af, bfr, kv, 0, 0, 0); }
                  Sacc[em] = Sacc[em] * de + kv * dk; } }
            __syncthreads();
        }
    }
}
__device__ void hgrn_readout(const Params& p, const int TID, const int BID, const int GRD) {
    bf16_t* OF = (bf16_t*)(p.ws + WS_HB); const bf16_t* OBp = (const bf16_t*)(p.ws + WS_OB); const bf16_t* P = (const bf16_t*)(p.ws + WS_BIG);
    const int wave = TID >> 6, lane = TID & 63;
    for (int row = BID * 8 + wave; row < TT; row += GRD * 8) {
        const int c0 = lane * 16;
        float o[16], gg[16]; float ss = 0.f;
#pragma unroll
        for (int hf = 0; hf < 2; ++hf) { const u32x4 a = *(const u32x4*)(OF + (size_t)row * D + c0 + hf * 8), bb = *(const u32x4*)(OBp + (size_t)row * D + c0 + hf * 8);
            const u32x4 gv = *(const u32x4*)(P + (size_t)row * 4096 + 3072 + c0 + hf * 8);
#pragma unroll
            for (int i = 0; i < 4; ++i) { const float v0 = bf2f(a[i] & 0xffffu) + bf2f(bb[i] & 0xffffu), v1 = bf2f(a[i] >> 16) + bf2f(bb[i] >> 16);
                o[hf * 8 + i * 2] = v0; o[hf * 8 + i * 2 + 1] = v1; ss += v0 * v0 + v1 * v1;
                gg[hf * 8 + i * 2] = bf2f(gv[i] & 0xffffu); gg[hf * 8 + i * 2 + 1] = bf2f(gv[i] >> 16); } }
        ss += __shfl_xor(ss, 1, 64); ss += __shfl_xor(ss, 2, 64); ss += __shfl_xor(ss, 4, 64);
        const float r = rsqrtf(ss * (1.f / 128.f) + RMS_EPS);
        unsigned w[8];
#pragma unroll
        for (int i = 0; i < 8; ++i) { const float nw0 = p.hgrn_norm_w[c0 + 2 * i], nw1 = p.hgrn_norm_w[c0 + 2 * i + 1];
            w[i] = cvt_pk_bf16(o[2 * i] * r * nw0 * gg[2 * i], o[2 * i + 1] * r * nw1 * gg[2 * i + 1]); }
        *(u32x4*)(OF + (size_t)row * D + c0) = (u32x4){w[0], w[1], w[2], w[3]};
        *(u32x4*)(OF + (size_t)row * D + c0 + 8) = (u32x4){w[4], w[5], w[6], w[7]};
    }
}

__device__ void na_phase(const Params& p, LAS unsigned char* lds, const int TID, const int BID, const int GRD) {
    const bf16_t* QK = (const bf16_t*)(p.ws + WS_BIG); const bf16_t* VTg = (const bf16_t*)(p.ws + WS_VT2); bf16_t* O = (bf16_t*)(p.ws + WS_HB);
    const int wave = TID >> 6, lane = TID & 63, l15 = lane & 15, quad = lane >> 4;
    constexpr int KC = 2048, VC = 2048 + 36864;
    const LAS float* rpl = (const LAS float*)lds;
    const int u0 = (int)((long)BID * 2048 / GRD), u1 = (int)((long)(BID + 1) * 2048 / GRD);
    int bh_cached = -1;
    for (int u = u0; u < u1; ++u) {
        const int bh = u >> 4, rp = u & 15, b = bh >> 4, h = bh & 15;
        if (bh != bh_cached) {
            __syncthreads();
            for (int i = TID; i < 465; i += 512) ((LAS float*)lds)[i] = p.na_rpb[h * 465 + i] * 1.44269504f;
#pragma unroll
            for (int it = 0; it < 4; ++it) { const int idx = TID + it * 512; const int key = idx >> 3, seg = idx & 7;
                *(LAS u32x4*)(lds + KC + key * 144 + seg * 16) = *(const u32x4*)(QK + (size_t)(TL + b * CTXL + key) * 2048 + 1024 + h * 64 + seg * 8); }
#pragma unroll
            for (int it = 0; it < 4; ++it) { const int idx = TID + it * 512; const int e = idx >> 5, seg = idx & 31;
                *(LAS u32x4*)(lds + VC + e * 528 + seg * 16) = *(const u32x4*)(VTg + (size_t)(h * 64 + e) * TT + TL + b * CTXL + seg * 8); }
            __syncthreads();
            bh_cached = bh;
        }
        const int jb = wave & 3, r = rp * 2 + (wave >> 2);
        const int qrow = b * SEQ + r * 64 + jb * 16 + l15;
        const bf16x8 qf0 = *(const bf16x8*)(QK + (size_t)qrow * 2048 + h * 64 + quad * 8), qf1 = *(const bf16x8*)(QK + (size_t)qrow * 2048 + h * 64 + 32 + quad * 8);
        const int rs = r - 4 < 0 ? 0 : (r - 4 > 24 ? 24 : r - 4);
        const int bs = jb * 16 - 8 < 0 ? 0 : (jb * 16 - 8 > 32 ? 32 : jb * 16 - 8);
        const int qc = jb * 16 + l15; const int wst = qc - 8 < 0 ? 0 : (qc - 8 > 48 ? 48 : qc - 8);
        int dcv[8]; unsigned okm = 0u;
#pragma unroll
        for (int t = 0; t < 2; ++t)
#pragma unroll
            for (int j = 0; j < 4; ++j) { const int kc = bs + quad * 8 + 4 * t + j; const bool ok = kc >= wst && kc < wst + 16; int dc = kc - qc + 15; dc = dc < 0 ? 0 : (dc > 30 ? 30 : dc); dcv[t * 4 + j] = dc; okm |= ok ? (1u << (t * 4 + j)) : 0u; }
        float m = -1e30f, l = 0.f;
        f32x4 o[4];
#pragma unroll
        for (int i = 0; i < 4; ++i) o[i] = (f32x4){0.f, 0.f, 0.f, 0.f};
        const bf16_t* Kb = QK + 1024 + h * 64 + quad * 8;
        const bf16_t* Vb = VTg + (size_t)(h * 64 + l15) * TT + quad * 8;
#define NA_BASE(grp) ((grp) >= 8 ? b * SEQ + (rs + (grp) - 8) * 64 + bs : TL + b * CTXL + (grp) * 32)
#define NA_LOAD_CTX(grp, KF, VF) do { \
            _Pragma("unroll") for (int t = 0; t < 2; ++t) { const int kb_ = KC + ((grp) * 32 + 8 * (l15 >> 2) + 4 * t + (l15 & 3)) * 144 + quad * 16; KF[t][0] = *(const LAS bf16x8*)(lds + kb_); KF[t][1] = *(const LAS bf16x8*)(lds + kb_ + 64); } \
            _Pragma("unroll") for (int et = 0; et < 4; ++et) VF[et] = *(const LAS bf16x8*)(lds + VC + (et * 16 + l15) * 528 + ((grp) * 32 + quad * 8) * 2); } while (0)
#define NA_LOAD(grp, KF, VF) do { const int _base = NA_BASE(grp); \
            _Pragma("unroll") for (int t = 0; t < 2; ++t) { const bf16_t* kp_ = Kb + (size_t)(_base + 8 * (l15 >> 2) + 4 * t + (l15 & 3)) * 2048; KF[t][0] = *(const bf16x8*)kp_; KF[t][1] = *(const bf16x8*)(kp_ + 32); } \
            _Pragma("unroll") for (int et = 0; et < 4; ++et) { const bf16_t* vp_ = Vb + (size_t)(et * 16) * TT + _base; VF[et] = *(const bf16x8*)vp_; } } while (0)
#define NA_COMPUTE(grp, KF, VF) do { const bool loc = (grp) >= 8; const int a = (grp) - 8; \
            f32x4 st[2]; \
            _Pragma("unroll") for (int t = 0; t < 2; ++t) { f32x4 s_ = {0.f, 0.f, 0.f, 0.f}; \
                s_ = __builtin_amdgcn_mfma_f32_16x16x32_bf16(KF[t][0], qf0, s_, 0, 0, 0); \
                s_ = __builtin_amdgcn_mfma_f32_16x16x32_bf16(KF[t][1], qf1, s_, 0, 0, 0); st[t] = s_ * (0.125f * 1.44269504f); } \
            if (loc) { const LAS float* rp = rpl + (rs + a - r + 7) * 31; \
                _Pragma("unroll") for (int t = 0; t < 2; ++t) _Pragma("unroll") for (int j = 0; j < 4; ++j) st[t][j] = ((okm >> (t * 4 + j)) & 1u) ? st[t][j] + rp[dcv[t * 4 + j]] : -1e30f; } \
            float mx = fmaxf(fmaxf(fmaxf(st[0][0], st[0][1]), fmaxf(st[0][2], st[0][3])), fmaxf(fmaxf(st[1][0], st[1][1]), fmaxf(st[1][2], st[1][3]))); \
            mx = fmaxf(mx, __shfl_xor(mx, 16, 64)); mx = fmaxf(mx, __shfl_xor(mx, 32, 64)); \
            const float mn = fmaxf(m, mx); \
            if (__builtin_amdgcn_ballot_w64(mn != m) != 0ull) { const float corr = __builtin_amdgcn_exp2f(m - mn); l *= corr; \
                _Pragma("unroll") for (int et = 0; et < 4; ++et) o[et] = o[et] * corr; } \
            m = mn; \
            float pv[8]; float ps = 0.f; \
            _Pragma("unroll") for (int t = 0; t < 2; ++t) _Pragma("unroll") for (int j = 0; j < 4; ++j) { const float e_ = __builtin_amdgcn_exp2f(st[t][j] - mn); pv[t * 4 + j] = e_; ps += e_; } \
            l += ps; \
            union { bf16x8 v; unsigned u[4]; } pf; \
            pf.u[0] = cvt_pk_bf16(pv[0], pv[1]); pf.u[1] = cvt_pk_bf16(pv[2], pv[3]); pf.u[2] = cvt_pk_bf16(pv[4], pv[5]); pf.u[3] = cvt_pk_bf16(pv[6], pv[7]); \
            _Pragma("unroll") for (int et = 0; et < 4; ++et) o[et] = __builtin_amdgcn_mfma_f32_16x16x32_bf16(VF[et], pf.v, o[et], 0, 0, 0); } while (0)
        bf16x8 kA[2][2], kB[2][2], kC[2][2]; bf16x8 vA[4], vB[4], vC[4];
        NA_LOAD(8, kA, vA); NA_LOAD(9, kB, vB);
#pragma unroll 1
        for (int g = 0; g < 8; ++g) { NA_LOAD_CTX(g, kC, vC); NA_COMPUTE(g, kC, vC); }
        NA_LOAD(10, kC, vC);
#pragma unroll 1
        for (int g = 8; g < 16; g += 3) {
            NA_COMPUTE(g, kA, vA); if (g + 3 < 16) NA_LOAD(g + 3, kA, vA);
            if (g + 1 < 16) { NA_COMPUTE(g + 1, kB, vB); if (g + 4 < 16) NA_LOAD(g + 4, kB, vB); }
            if (g + 2 < 16) { NA_COMPUTE(g + 2, kC, vC); if (g + 5 < 16) NA_LOAD(g + 5, kC, vC); }
        }
#undef NA_BASE
#undef NA_LOAD
#undef NA_LOAD_CTX
#undef NA_COMPUTE
        l += __shfl_xor(l, 16, 64); l += __shfl_xor(l, 32, 64);
        const float inv = 1.f / l;
#pragma unroll
        for (int et = 0; et < 4; ++et) { u32x2 w; w.x = cvt_pk_bf16(o[et][0] * inv, o[et][1] * inv); w.y = cvt_pk_bf16(o[et][2] * inv, o[et][3] * inv);
            *(u32x2*)(O + (size_t)qrow * D + h * 64 + et * 16 + quad * 4) = w; }
    }
}

#define XB_TMO      128
#define XB_XCNT(j)  (256  + 64 * (j))
#define XB_XSUB(j)  (1280 + 64 * (j))
#define XB_XGEN(j)  (2304 + 64 * (j))
#define XB_TOP      3328
#define XB_TOPGEN   3392
#define XCD_BAR_WORDS 3456
#define XB_SPIN_CAP (1u << 18)
__device__ __forceinline__ unsigned xb_ld(unsigned* p)              { return __hip_atomic_load(p, __ATOMIC_RELAXED, __HIP_MEMORY_SCOPE_AGENT); }
__device__ __forceinline__ unsigned xb_add(unsigned* p, unsigned v) { return __hip_atomic_fetch_add(p, v, __ATOMIC_RELAXED, __HIP_MEMORY_SCOPE_AGENT); }
__device__ __forceinline__ unsigned xb_xcc_id() { return (unsigned)__builtin_amdgcn_s_getreg((3 << 11) | 20) & 0xFu; }
#define XB_SPIN(cond, bar) do { unsigned _sp = 0; while (cond) { __builtin_amdgcn_s_sleep(1); \
    if ((++_sp & 255u) == 0u) { if (xb_ld(&(bar)[XB_TMO])) break; if (_sp > XB_SPIN_CAP) { atomicAdd(&(bar)[XB_TMO], 1u); break; } } } } while (0)
struct XcdBarrier { unsigned* bar; unsigned x; volatile LAS unsigned* st; };
__device__ __forceinline__ XcdBarrier xcd_barrier_post(unsigned* bar, volatile LAS unsigned* st) {
    XcdBarrier b; b.bar = bar; b.x = xb_xcc_id(); b.st = st;
    if (threadIdx.x == 0) (void)xb_add(&bar[XB_XCNT(b.x)], 1u);
    return b;
}
__device__ __forceinline__ void xcd_barrier_complete(unsigned* bar, unsigned x, unsigned& nloc, unsigned& nx) {
    const unsigned G = gridDim.x * gridDim.y * gridDim.z;
    unsigned sum, cnt, mine, sp = 0u;
    for (;;) {
        sum = 0u; cnt = 0u; mine = 0u;
#pragma unroll
        for (unsigned j = 0; j < 16; ++j) { const unsigned c = xb_ld(&bar[XB_XCNT(j)]); sum += c; cnt += (c > 0u) ? 1u : 0u; mine = (j == x) ? c : mine; }
        if (sum == G) break;
        __builtin_amdgcn_s_sleep(1);
        if ((++sp & 255u) == 0u) { if (xb_ld(&bar[XB_TMO])) break; if (sp > XB_SPIN_CAP) { atomicAdd(&bar[XB_TMO], 1u); break; } }
    }
    nloc = mine > 0u ? mine : 1u; nx = cnt > 0u ? cnt : 1u;
}
__device__ __forceinline__ void xcd_barrier(const XcdBarrier& b) {
    asm volatile("s_waitcnt vmcnt(0)" ::: "memory");
    __syncthreads();
    if (threadIdx.x == 0) {
        unsigned* bar = b.bar;
        __builtin_amdgcn_s_waitcnt(0);
        unsigned nloc = b.st[0], nx = b.st[1];
        if (nloc == 0u) { xcd_barrier_complete(bar, b.x, nloc, nx); b.st[0] = nloc; b.st[1] = nx; }
        const unsigned old = xb_add(&bar[XB_XSUB(b.x)], 1u);
        const unsigned gen = old / nloc;
        if (old + 1u == (gen + 1u) * nloc) {
            __builtin_amdgcn_fence(__ATOMIC_RELEASE, "agent");
            asm volatile("s_waitcnt vmcnt(0)" ::: "memory");
            const unsigned og = xb_add(&bar[XB_TOP], 1u);
            const unsigned tg = og / nx;
            if (og + 1u == (tg + 1u) * nx) xb_add(&bar[XB_TOPGEN], 1u);
            else XB_SPIN(xb_ld(&bar[XB_TOPGEN]) == tg, bar);
            __builtin_amdgcn_fence(__ATOMIC_ACQUIRE, "agent");
            xb_add(&bar[XB_XGEN(b.x)], 1u);
            asm volatile("s_waitcnt vmcnt(0)" ::: "memory");
        } else {
            XB_SPIN(xb_ld(&bar[XB_XGEN(b.x)]) == gen, bar);
            __builtin_amdgcn_fence(__ATOMIC_ACQUIRE, "agent");
            asm volatile("s_waitcnt vmcnt(0)" ::: "memory");
        }
    }
    __syncthreads();
}

enum { OP_PRO = 0, OP_POOLPREP, OP_GEMM_RESID, OP_GEMM_BF16, OP_SCAN, OP_READOUT, OP_NA, OP_LN1, OP_FFN1, OP_LN2 };
__global__ void __launch_bounds__(512, 2) mega(Params p, int ph_lo, int ph_hi) {
    extern __shared__ __attribute__((aligned(16))) unsigned char lds_raw[];
    LAS unsigned char* lds = (LAS unsigned char*)lds_raw;
    cg::grid_group grid = cg::this_grid();
    volatile LAS unsigned* bst = (volatile LAS unsigned*)(lds + 131072);
    if (threadIdx.x < 4) bst[threadIdx.x] = 0u;
    __syncthreads();
    XcdBarrier xbar = xcd_barrier_post((unsigned*)(p.ws + WS_BAR), bst);
    for (int ph = ph_lo; ph < ph_hi; ++ph) {
        int layer, idx, nmix;
        if (ph < 7) { layer = 0; idx = ph - 1; nmix = 2; } else if (ph < 15) { layer = 1; idx = ph - 7; nmix = 4; } else if (ph < 22) { layer = 2; idx = ph - 15; nmix = 3; } else { layer = 3; idx = ph - 22; nmix = 2; }
        int op; bool ffn2 = false;
        if (ph == 0) op = OP_PRO;
        else if (idx >= nmix) { const int k = idx - nmix; op = k == 0 ? OP_LN1 : k == 1 ? OP_FFN1 : k == 2 ? OP_GEMM_RESID : OP_LN2; ffn2 = (k == 2); }
        else if (layer == 0 || layer == 3) op = idx == 0 ? OP_POOLPREP : OP_GEMM_RESID;
        else if (layer == 1) op = idx == 0 ? OP_GEMM_BF16 : idx == 1 ? OP_SCAN : idx == 2 ? OP_READOUT : OP_GEMM_RESID;
        else op = idx == 0 ? OP_GEMM_BF16 : idx == 1 ? OP_NA : OP_GEMM_RESID;
        unsigned char* ws = p.ws; asm volatile("" : "+s"(ws));
        int G = gridDim.x, bid = blockIdx.x, tid = threadIdx.x; asm volatile("" : "+s"(G), "+s"(bid), "+v"(tid));
        const float* modl = (const float*)(ws + WS_MOD) + (size_t)layer * 9 * 6144;
        float* XC = (float*)(ws + WS_XC);
        const int Mrows = (layer >= 3) ? TL : TT;
        const int Mpost = (layer >= 2) ? TL : TT;
        if (op == OP_PRO) {
            conv_jobs(p, 0, 4, lds, tid, bid, G); __syncthreads(); mod_gemv(p, lds, 0, 1, tid, bid, G); lb_compute(p, tid, bid, G);
        } else if (op == OP_POOLPREP) {
            pool_prep(layer == 0 ? p.x : p.out, layer == 0 ? p.ctx : XC, Mrows, modl + 1024, (bf16_t*)(ws + WS_HB), tid, bid, G);
        } else if (op == OP_GEMM_RESID) {
            const void* A = ws + WS_HB; const void* Bt; int M = Mpost, K = 1024; unsigned lda = 2048u, ldb = 2048u, acol = 0u;
            const float* sL = p.out; const float* sC = XC; const float* gate = modl + 2048; const float* scale = nullptr;
            if (ffn2) { A = ws + WS_BIG; Bt = ws + (layer == 0 ? W_FO0 : layer == 1 ? W_FO1 : layer == 2 ? W_FO2 : W_FO3); K = FH; lda = 5632u; ldb = 5632u; gate = modl + 5120; }
            else if (layer == 0 || layer == 3) { Bt = ws + (layer == 0 ? W_POOL0 : W_POOL1); M = Mrows; K = 256; ldb = 512u; acol = 512u; scale = p.pool_scale + (layer == 0 ? 0 : 1024);
                if (layer == 0) { sL = p.x; sC = p.ctx; } }
            else if (layer == 1) { Bt = ws + W_HOUT; M = TT; }
            else { Bt = ws + W_NOUT; M = TL; }
            pg8::Sched S; S.init1(A, Bt, M, 1024, lda, ldb, acol, G, bid);
            pg8::EpiResid E{sL, sC, p.out, XC, gate, scale};
            pg8::gemm_phase<pg8::EpiResid>(lds, K, S, E, tid, bid, G);
            if (layer <= 1 && (ffn2 || layer == 0) && G > 64) { const int ja = layer == 0 ? (ffn2 ? 6 : 4) : 10, jb = layer == 0 ? (ffn2 ? 10 : 6) : 20;
                if (bid >= 32) { __syncthreads(); conv_jobs(p, ja, jb, lds, tid, bid - 32, G - 32);
                    if (layer == 0 && ffn2) { __syncthreads(); mod_gemv(p, lds, 1, 4, tid, bid - 32, G - 32); } } }
            else if (layer <= 1 && (ffn2 || layer == 0)) { const int ja = layer == 0 ? (ffn2 ? 6 : 4) : 10, jb = layer == 0 ? (ffn2 ? 10 : 6) : 20; __syncthreads(); conv_jobs(p, ja, jb, lds, tid, bid, G); if (layer == 0 && ffn2) { __syncthreads(); mod_gemv(p, lds, 1, 4, tid, bid, G); } }
        } else if (op == OP_GEMM_BF16) {
            const unsigned char* W = ws + (layer == 1 ? W_HIN : W_QKV); const int N0 = layer == 1 ? 4096 : 2048;
            pg8::Sched S; S.init1(ws + WS_HB, W, TT, N0, 2048u, 2048u, 0u, G, bid);
            S.add2(W + (size_t)N0 * 2048, ws + WS_HB, 1024, TT);
            pg8::EpiBf16P E{(bf16_t*)(ws + WS_BIG), (bf16_t*)(ws + (layer == 1 ? WS_VT : WS_VT2)), N0, TT, (const float*)(ws + WS_LB), layer == 1 ? 1 : 0};
            pg8::gemm_phase<pg8::EpiBf16P>(lds, 1024, S, E, tid, bid, G);
        } else if (op == OP_SCAN) {
            scan_phase(p, lds, tid, bid, G);
        } else if (op == OP_READOUT) {
            hgrn_readout(p, tid, bid, G);
        } else if (op == OP_NA) {
            na_phase(p, lds, tid, bid, G);
        } else if (op == OP_LN1) {
            ln_pass(p.out, XC, Mpost, p.ln_g + (layer * 2) * 1024, p.ln_b + (layer * 2) * 1024, modl + 4096, modl + 3072, (bf16_t*)(ws + WS_HB), tid, bid, G);
        } else if (op == OP_FFN1) {
            pg8::Sched S; S.init1(ws + WS_HB, ws + (layer == 0 ? W_FI0 : layer == 1 ? W_FI1 : layer == 2 ? W_FI2 : W_FI3), Mpost, 5632, 2048u, 2048u, 0u, G, bid);
            pg8::EpiSwiGLU E{(bf16_t*)(ws + WS_BIG)};
            pg8::gemm_phase<pg8::EpiSwiGLU>(lds, 1024, S, E, tid, bid, G);
        } else {
            const bool need_hb = (layer == 0 || layer == 1);
            const float* modn = (const float*)(ws + WS_MOD) + (size_t)(layer + 1 < 4 ? layer + 1 : 3) * 9 * 6144;
            ln_pass(p.out, XC, Mpost, p.ln_g + (layer * 2 + 1) * 1024, p.ln_b + (layer * 2 + 1) * 1024, modn + 1024, modn, need_hb ? (bf16_t*)(ws + WS_HB) : nullptr, tid, bid, G);
        }
        if (ph + 1 < ph_hi) { if (ph == 0) grid.sync(); else xcd_barrier(xbar); }
    }
}
#ifndef PH_LIMIT
#define PH_LIMIT 28
#endif
constexpr int N_PHASES = PH_LIMIT;

extern "C" void kernel_launch(void* const* d_in, const int* in_sizes, int n_in, void* d_out, int out_size, void* d_ws, size_t ws_size, hipStream_t stream) {
    static int grid = 0;
    if (grid == 0) {
        if (n_in != 19 || out_size != TL * D || ws_size < WS_END) { fprintf(stderr, "kernel_launch: unexpected problem (n_in %d out %d ws %zu need %zu)\n", n_in, out_size, ws_size, (size_t)WS_END); grid = -1; return; }
        int dev = 0, cus = 0, per_cu = 0;
        hipGetDevice(&dev); hipDeviceGetAttribute(&cus, hipDeviceAttributeMultiprocessorCount, dev);
        if (hipFuncSetAttribute((const void*)mega, hipFuncAttributeMaxDynamicSharedMemorySize, LDS_BYTES) != hipSuccess) { fprintf(stderr, "kernel_launch: hipFuncSetAttribute failed\n"); grid = -1; return; }
        if (hipOccupancyMaxActiveBlocksPerMultiprocessor(&per_cu, (const void*)mega, 512, LDS_BYTES) != hipSuccess || per_cu < 1) { fprintf(stderr, "kernel_launch: occupancy query failed (%d)\n", per_cu); (void)hipGetLastError(); per_cu = 1; }
        grid = cus * per_cu;
        if (grid > 256) grid = 256;
    }
    if (grid < 0) return;
    Params p{};
    const float** pp = (const float**)&p;
    for (int i = 0; i < 19; ++i) pp[i] = (const float*)d_in[i];
    p.out = (float*)d_out; p.ws = (unsigned char*)d_ws;
#if MK_MULTI
    for (int ph = 0; ph < N_PHASES; ++ph) { int lo = ph, hi = ph + 1; hipLaunchKernelGGL(mega, dim3(grid), dim3(512), LDS_BYTES, stream, p, lo, hi); }
#else
    int lo = 0, hi = N_PHASES;
    (void)hipMemsetAsync((unsigned char*)d_ws + WS_BAR, 0, XCD_BAR_WORDS * 4, stream);
    void* args[] = {&p, &lo, &hi};
    hipError_t e = hipLaunchCooperativeKernel((const void*)mega, dim3(grid), dim3(512), args, LDS_BYTES, stream);
    if (e != hipSuccess) fprintf(stderr, "cooperative launch failed: %s (grid %d)\n", hipGetErrorString(e), grid);
#endif
}
```

```cpp
#include <hip/hip_runtime.h>
#include <hip/hip_cooperative_groups.h>
#include <cstdio>
#include <cstdint>
namespace cg = cooperative_groups;

#ifndef MK_MULTI
#define MK_MULTI 0
#endif

#define LAS __attribute__((address_space(3)))
typedef unsigned short bf16_t;
typedef short bf16x8 __attribute__((ext_vector_type(8)));
typedef float f32x4 __attribute__((ext_vector_type(4)));
typedef unsigned u32x4 __attribute__((ext_vector_type(4)));
typedef unsigned u32x2 __attribute__((ext_vector_type(2)));

constexpr int D = 1024, NB = 8, SEQ = 2048, CTXL = 256, TL = NB * SEQ, TC = NB * CTXL, TT = TL + TC, FH = 2816;
constexpr float ALPHA = 1.6817928305074292f;
constexpr float LN_EPS = 1e-6f, RMS_EPS = 1e-6f;
constexpr size_t MiB = 1u << 20;
constexpr size_t WS_MOD = 0;
constexpr size_t WS_LB = 1 * MiB;
constexpr size_t WS_BAR = 1 * MiB + 65536;
constexpr size_t WS_WE = 2 * MiB;
constexpr size_t W_POOL0 = WS_WE;
constexpr size_t W_FI0 = W_POOL0 + 512 * 1024;
constexpr size_t W_FO0 = W_FI0 + 11 * MiB;
constexpr size_t W_HIN = W_FO0 + 11 * MiB / 2;
constexpr size_t W_HOUT = W_HIN + 10 * MiB;
constexpr size_t W_FI1 = W_HOUT + 2 * MiB;
constexpr size_t W_FO1 = W_FI1 + 11 * MiB;
constexpr size_t WS_XC = 48 * MiB;
constexpr size_t WS_HB = 56 * MiB;
constexpr size_t WS_OB = 92 * MiB;
constexpr size_t WS_BIG = 128 * MiB;
constexpr size_t WS_VT = WS_BIG + 144 * MiB;
constexpr size_t WS_VT2 = WS_BIG + 72 * MiB;
constexpr size_t WS_WL = WS_BIG + 120 * MiB;
constexpr size_t W_QKV = WS_WL;
constexpr size_t W_NOUT = W_QKV + 6 * MiB;
constexpr size_t W_FI2 = W_NOUT + 2 * MiB;
constexpr size_t W_FO2 = W_FI2 + 11 * MiB;
constexpr size_t W_POOL1 = W_FO2 + 11 * MiB / 2;
constexpr size_t W_FI3 = W_POOL1 + 512 * 1024;
constexpr size_t W_FO3 = W_FI3 + 11 * MiB;
constexpr size_t WS_END = 308 * MiB;
constexpr int LDS_BYTES = 131072 + 1024;

struct Params {
    const float *x, *c, *ctx, *c_ctx, *mod_w, *mod_b, *ln_g, *ln_b, *ffn_w_in, *ffn_w_out, *pool_w, *pool_scale,
        *hgrn_w_in, *hgrn_lb, *hgrn_norm_w, *hgrn_w_out, *na_w_qkv, *na_rpb, *na_w_out;
    float* out; unsigned char* ws;
};

__device__ __forceinline__ float bf2f(unsigned v) { return __uint_as_float(v << 16); }
typedef __bf16 bf16x2_t __attribute__((ext_vector_type(2)));
__device__ __forceinline__ unsigned cvt_pk_bf16(float lo, float hi) { bf16x2_t v = {(__bf16)lo, (__bf16)hi}; return __builtin_bit_cast(unsigned, v); }
__device__ __forceinline__ bf16_t f2bf(float f) { return (bf16_t)(cvt_pk_bf16(f, 0.f) & 0xffffu); }
__device__ __forceinline__ float silu_f(float x) { return x * __builtin_amdgcn_rcpf(1.f + __expf(-x)); }
__device__ __forceinline__ float wave_sum(float v) {
#pragma unroll
    for (int o = 32; o > 0; o >>= 1) v += __shfl_xor(v, o, 64);
    return v;
}

namespace pg8 {
constexpr int BM = 256, BK = 64, HALF = 128, HTB = HALF * BK * 2, STAGE_BYTES = 8 * HTB, NXCD = 8, WGM = 8;
__host__ __device__ __forceinline__ int lds_byte(int r, int c) { const int st = (r >> 4) * 2 + (c >> 5), rr = r & 15, cc = c & 31, ob = rr * 64 + cc * 2; return st * 1024 + (ob ^ (((ob >> 9) & 1) << 5)); }
__host__ __device__ __forceinline__ void stage_rc(int b, int& R, int& C) { const int st = b / 1024, sb = b % 1024, swz = sb ^ (((sb >> 9) & 1) << 5); R = (st >> 1) * 16 + swz / 64; C = (st & 1) * 32 + (swz % 64) / 2; }
__host__ __device__ __forceinline__ int perm32(int rho) { const int n = rho >> 4, i = rho & 15; return 8 * (i >> 2) + 4 * n + (i & 3); }

struct Unit { const char* a; const char* b; int pm, pn, job; };
struct Sched {
    const char *A0, *B0, *A1, *B1; int nM0, nN0, nM1, nN1, n0, ntot, G, c; unsigned lda_b, ldb_b, acol_pn_b;
    __device__ void init1(const void* A, const void* Bt, int M, int N, unsigned lda, unsigned ldb, unsigned acol, int G_, int c_) {
        A0 = (const char*)A; B0 = (const char*)Bt; A1 = A0; B1 = B0; nM0 = M / BM; nN0 = N / BM; nM1 = 0; nN1 = 1; n0 = nM0 * nN0; ntot = n0; G = G_; c = c_; lda_b = lda; ldb_b = ldb; acol_pn_b = acol; }
    __device__ void add2(const void* A, const void* Bt, int M, int N) { A1 = (const char*)A; B1 = (const char*)Bt; nM1 = M / BM; nN1 = N / BM; ntot = n0 + nM1 * nN1; }
    __device__ bool next(int i, Unit& u) const {
        const long L = (long)i * G + c; if (L >= ntot) return false;
        const int job = L >= n0; int wgid = (int)L - (job ? n0 : 0);
        const int nM = job ? nM1 : nM0, nN = job ? nN1 : nN0, nwg = nM * nN;
        { const int q = nwg / NXCD, r = nwg % NXCD, xcd = wgid % NXCD, off = wgid / NXCD; wgid = (xcd < r ? xcd * (q + 1) : r * (q + 1) + (xcd - r) * q) + off; }
        const int nig = WGM * nN, gid = wgid / nig, fm = gid * WGM, gsz = (nM - fm) < WGM ? (nM - fm) : WGM;
        u.pm = fm + ((wgid % nig) % gsz); u.pn = (wgid % nig) / gsz; u.job = job;
        u.a = (job ? A1 : A0) + (size_t)u.pm * BM * lda_b + (size_t)u.pn * acol_pn_b; u.b = (job ? B1 : B0) + (size_t)u.pn * BM * ldb_b; return true;
    }
};

struct EpiBf16P {
    static constexpr bool PERM = true;
    bf16_t* O0; bf16_t* O1; int ldc0, ldc1; const float* lbp; int hg;
    __device__ __forceinline__ void operator()(const f32x4 (&acc)[2][2][4][2], const Unit& u, int wr, int wc, int fr, int fq) const {
        bf16_t* base = u.job ? O1 : O0; const int ldc = u.job ? ldc1 : ldc0;
        const int row0 = u.pm * BM + wr * 64 + fr, col0 = u.pn * BM + wc * 32 + 8 * fq;
        const int kind = (!hg || u.job) ? 0 : ((u.pn >= 4 && u.pn < 12) ? 2 : 1);
        f32x4 lb[2][2];
        if (kind == 2) { const float* lp = lbp + (col0 - 1024);
#pragma unroll
            for (int bj = 0; bj < 2; ++bj) { lb[bj][0] = *(const f32x4*)(lp + bj * HALF); lb[bj][1] = *(const f32x4*)(lp + bj * HALF + 4); } }
#pragma unroll
        for (int ai = 0; ai < 2; ++ai)
#pragma unroll
            for (int m = 0; m < 4; ++m) { bf16_t* rowp = base + (size_t)(row0 + ai * HALF + m * 16) * ldc + col0;
#pragma unroll
                for (int bj = 0; bj < 2; ++bj) { f32x4 v0 = acc[ai][bj][m][0], v1 = acc[ai][bj][m][1];
                    if (kind == 1) {
#pragma unroll
                        for (int j = 0; j < 4; ++j) { v0[j] = silu_f(v0[j]); v1[j] = silu_f(v1[j]); } }
                    else if (kind == 2) {
#pragma unroll
                        for (int j = 0; j < 4; ++j) { const float s0 = __builtin_amdgcn_rcpf(1.f + __expf(-v0[j])), s1 = __builtin_amdgcn_rcpf(1.f + __expf(-v1[j]));
                            v0[j] = __log2f(lb[bj][0][j] + (1.f - lb[bj][0][j]) * s0); v1[j] = __log2f(lb[bj][1][j] + (1.f - lb[bj][1][j]) * s1); } }
                    u32x4 w; w.x = cvt_pk_bf16(v0[0], v0[1]); w.y = cvt_pk_bf16(v0[2], v0[3]); w.z = cvt_pk_bf16(v1[0], v1[1]); w.w = cvt_pk_bf16(v1[2], v1[3]);
                    *(u32x4*)(rowp + bj * HALF) = w; } }
    }
};
struct EpiSwiGLU {
    static constexpr bool PERM = true;
    bf16_t* U;
    __device__ __forceinline__ void operator()(const f32x4 (&acc)[2][2][4][2], const Unit& u, int wr, int wc, int fr, int fq) const {
        const int row0 = u.pm * BM + wr * 64 + fr, col0 = u.pn * HALF + wc * 32 + 8 * fq;
#pragma unroll
        for (int ai = 0; ai < 2; ++ai)
#pragma unroll
            for (int m = 0; m < 4; ++m) { bf16_t* rowp = U + (size_t)(row0 + ai * HALF + m * 16) * FH + col0;
                float r[8];
#pragma unroll
                for (int n = 0; n < 2; ++n)
#pragma unroll
                    for (int j = 0; j < 4; ++j) { const float g = acc[ai][0][m][n][j], up = acc[ai][1][m][n][j]; r[n * 4 + j] = silu_f(g) * up; }
                u32x4 w; w.x = cvt_pk_bf16(r[0], r[1]); w.y = cvt_pk_bf16(r[2], r[3]); w.z = cvt_pk_bf16(r[4], r[5]); w.w = cvt_pk_bf16(r[6], r[7]);
                *(u32x4*)rowp = w; }
    }
};
struct EpiResid {
    static constexpr bool PERM = false;
    const float* srcL; const float* srcC; float* dstL; float* dstC; const float* gate; const float* scale;
    __device__ __forceinline__ void operator()(const f32x4 (&acc)[2][2][4][2], const Unit& u, int wr, int wc, int fr, int fq) const {
        const int row0 = u.pm * BM + wr * 64 + fr, col0 = u.pn * BM + wc * 32 + 4 * fq;
        const bool lat = row0 < TL;
#pragma unroll
        for (int ai = 0; ai < 2; ++ai)
#pragma unroll
            for (int m = 0; m < 4; ++m) { const int row = row0 + ai * HALF + m * 16; const int mr = lat ? (row >> 11) : 8;
                const float* sp = lat ? srcL + (size_t)row * D : srcC + (size_t)(row - TL) * D; float* dp = lat ? dstL + (size_t)row * D : dstC + (size_t)(row - TL) * D;
                const float* gp = gate + mr * 6144;
#pragma unroll
                for (int bj = 0; bj < 2; ++bj)
#pragma unroll
                    for (int n = 0; n < 2; ++n) { const int col = col0 + bj * HALF + n * 16; f32x4 a = acc[ai][bj][m][n];
                        if (scale) a = a * *(const f32x4*)(scale + col);
                        const f32x4 xv = *(const f32x4*)(sp + col), gv = *(const f32x4*)(gp + col);
                        *(f32x4*)(dp + col) = xv * ALPHA + gv * a; } }
    }
};

template <class Epi>
__device__ __forceinline__ void gemm_phase(LAS unsigned char* lds, const int K, const Sched& S, const Epi& E, const int TID, const int BID, const int GRD) {
    const int tid = TID, wid = __builtin_amdgcn_readfirstlane(tid >> 6), lane = tid & 63, wr = wid >> 2, wc = wid & 3, fr = lane & 15, fq = lane >> 4;
    const int nt = K / BK;
    unsigned voffA[2], voffB[2];
#pragma unroll
    for (int i = 0; i < 2; ++i) { int R, C; stage_rc(tid * 16 + i * 8192, R, C); const int Rb = Epi::PERM ? ((R & ~31) + perm32(R & 31)) : R;
        voffA[i] = (unsigned)R * S.lda_b + (unsigned)C * 2u; voffB[i] = (unsigned)Rb * S.ldb_b + (unsigned)C * 2u; }
    const size_t kstep = (size_t)(BK * 2);
    const size_t hsA = (size_t)HALF * S.lda_b, hsB = (size_t)HALF * S.ldb_b;
    const unsigned ldsw = (unsigned)wid * 1024u;
    const int aoff = lds_byte(wr * 64 + fr, fq * 8), boff = lds_byte(wc * 32 + fr, fq * 8);
#define PG8_SA(b, h) (((b) * 2 + (h)) * HTB)
#define PG8_SB(b, h) ((4 + (b) * 2 + (h)) * HTB)
#define PG8_STAGE(bufoff, gbase, voff) do { _Pragma("unroll") for (int _i = 0; _i < 2; ++_i) \
        __builtin_amdgcn_global_load_lds((const unsigned*)((const char*)(gbase) + (voff)[_i]), (LAS unsigned*)(lds + (bufoff) + ldsw + _i * 8192), 16, 0, 0); } while (0)
#define PG8_LDA(dst, b, h) do { _Pragma("unroll") for (int m = 0; m < 4; ++m) _Pragma("unroll") for (int k = 0; k < 2; ++k) dst[m][k] = *(const LAS bf16x8*)(lds + PG8_SA(b, h) + aoff + m * 2048 + k * 1024); } while (0)
#define PG8_LDB(dst, b, h) do { _Pragma("unroll") for (int n = 0; n < 2; ++n) _Pragma("unroll") for (int k = 0; k < 2; ++k) dst[n][k] = *(const LAS bf16x8*)(lds + PG8_SB(b, h) + boff + n * 2048 + k * 1024); } while (0)
#define PG8_MMA(ai, bj, At, Bt) do { __builtin_amdgcn_s_setprio(1); _Pragma("unroll") for (int m = 0; m < 4; ++m) _Pragma("unroll") for (int n = 0; n < 2; ++n) _Pragma("unroll") for (int k = 0; k < 2; ++k) \
        acc[ai][bj][m][n] = __builtin_amdgcn_mfma_f32_16x16x32_bf16(Bt[n][k], At[m][k], acc[ai][bj][m][n], 0, 0, 0); __builtin_amdgcn_s_setprio(0); } while (0)
#define PG8_WAIT_V(n) asm volatile("s_waitcnt vmcnt(" #n ")" ::: "memory")
#define PG8_WAIT_L(n) asm volatile("s_waitcnt lgkmcnt(" #n ")" ::: "memory")
#define PG8_BAR __builtin_amdgcn_s_barrier()
#define PG8_SCHED __builtin_amdgcn_sched_barrier(0)
    Unit cur, nxt; int ui = 0;
    if (!S.next(0, cur)) return;
    f32x4 acc[2][2][4][2];
#pragma unroll
    for (int a = 0; a < 2; ++a)
#pragma unroll
        for (int b = 0; b < 2; ++b)
#pragma unroll
            for (int m = 0; m < 4; ++m)
#pragma unroll
                for (int n = 0; n < 2; ++n) acc[a][b][m][n] = (f32x4){0.f, 0.f, 0.f, 0.f};
    bf16x8 At[4][2], B0[2][2], B1[2][2];
    const char* cA = cur.a; const char* cB = cur.b;
    PG8_STAGE(PG8_SB(0, 0), cB, voffB); PG8_STAGE(PG8_SB(0, 1), cB + hsB, voffB); PG8_STAGE(PG8_SA(0, 0), cA, voffA); PG8_STAGE(PG8_SA(0, 1), cA + hsA, voffA);
    if (wr == 1) PG8_BAR;
    PG8_WAIT_V(2); PG8_BAR;
    PG8_STAGE(PG8_SB(1, 0), cB + kstep, voffB); PG8_STAGE(PG8_SA(1, 0), cA + kstep, voffA); PG8_STAGE(PG8_SB(1, 1), cB + hsB + kstep, voffB);
    PG8_WAIT_V(6); PG8_BAR;
    for (;;) {
        const bool has_next = S.next(ui + 1, nxt);
        const char* nA = has_next ? nxt.a : cA; const char* nB = has_next ? nxt.b : cB;
        for (int t = 0; t < nt; t += 2) {
            const bool last = (t == nt - 2);
            const char* a1 = cA + (size_t)(t + 1) * kstep;
            const char* a2 = last ? nA : cA + (size_t)(t + 2) * kstep; const char* b2 = last ? nB : cB + (size_t)(t + 2) * kstep;
            const char* a3 = a2 + kstep; const char* b3 = b2 + kstep;
            PG8_LDB(B0, 0, 0); PG8_LDB(B1, 0, 1); PG8_SCHED; PG8_LDA(At, 0, 0); PG8_STAGE(PG8_SA(1, 1), a1 + hsA, voffA);
            PG8_WAIT_V(8); PG8_WAIT_L(0); PG8_BAR; PG8_MMA(0, 0, At, B0); PG8_MMA(0, 1, At, B1); PG8_BAR; PG8_SCHED;
            PG8_LDA(At, 0, 1); PG8_STAGE(PG8_SB(0, 0), b2, voffB); PG8_STAGE(PG8_SB(0, 1), b2 + hsB, voffB); PG8_STAGE(PG8_SA(0, 0), a2, voffA);
            PG8_WAIT_V(8); PG8_WAIT_L(0); PG8_BAR; PG8_MMA(1, 0, At, B0); PG8_MMA(1, 1, At, B1); PG8_BAR; PG8_SCHED;
            PG8_LDB(B0, 1, 0); PG8_LDB(B1, 1, 1); PG8_SCHED; PG8_LDA(At, 1, 0); PG8_STAGE(PG8_SA(0, 1), a2 + hsA, voffA);
            PG8_WAIT_V(8); PG8_WAIT_L(0); PG8_BAR; PG8_MMA(0, 0, At, B0); PG8_MMA(0, 1, At, B1); PG8_BAR; PG8_SCHED;
            PG8_LDA(At, 1, 1); PG8_STAGE(PG8_SB(1, 0), b3, voffB); PG8_STAGE(PG8_SB(1, 1), b3 + hsB, voffB); PG8_STAGE(PG8_SA(1, 0), a3, voffA);
            PG8_WAIT_V(8); PG8_WAIT_L(0); PG8_BAR; PG8_MMA(1, 0, At, B0); PG8_MMA(1, 1, At, B1); PG8_BAR; PG8_SCHED;
        }
        if (wr == 0) PG8_BAR;
        E(acc, cur, wr, wc, fr, fq);
        if (!has_next) break;
#pragma unroll
        for (int a = 0; a < 2; ++a)
#pragma unroll
            for (int b = 0; b < 2; ++b)
#pragma unroll
                for (int m = 0; m < 4; ++m)
#pragma unroll
                    for (int n = 0; n < 2; ++n) acc[a][b][m][n] = (f32x4){0.f, 0.f, 0.f, 0.f};
        cur = nxt; cA = nA; cB = nB; ++ui;
        if (wr == 1) PG8_BAR;
    }
    PG8_WAIT_V(0);
    PG8_BAR;
#undef PG8_SA
#undef PG8_SB
#undef PG8_STAGE
#undef PG8_LDA
#undef PG8_LDB
#undef PG8_MMA
#undef PG8_WAIT_V
#undef PG8_WAIT_L
#undef PG8_BAR
#undef PG8_SCHED
}
}

__device__ __forceinline__ int map_row(int n, int mode) {
    if (mode == 1) { const int up = n >= FH; const int hh = up ? n - FH : n; return (hh >> 7) * 256 + up * 128 + (hh & 127); }
    if (mode == 2) { return n < 1024 ? n : (n < 2048 ? 4096 + (n - 1024) : n - 1024); }
    return n;
}
struct ConvJob { const float* src; bf16_t* dst; int K, N, mode; };
__device__ __forceinline__ void get_conv_job(const Params& p, int j, ConvJob& c) {
    unsigned char* ws = p.ws;
    c.mode = 0;
    if (j < 4) { c.src = p.pool_w + (size_t)j * 65536; c.dst = (bf16_t*)(ws + W_POOL0) + (size_t)j * 65536; c.K = 256; c.N = 256; }
    else if (j == 4) { c.src = p.ffn_w_in; c.dst = (bf16_t*)(ws + W_FI0); c.K = 1024; c.N = 5632; c.mode = 1; }
    else if (j == 5) { c.src = p.ffn_w_out; c.dst = (bf16_t*)(ws + W_FO0); c.K = 2816; c.N = 1024; }
    else if (j == 6) { c.src = p.hgrn_w_in; c.dst = (bf16_t*)(ws + W_HIN); c.K = 1024; c.N = 5120; c.mode = 2; }
    else if (j == 7) { c.src = p.hgrn_w_out; c.dst = (bf16_t*)(ws + W_HOUT); c.K = 1024; c.N = 1024; }
    else if (j == 8) { c.src = p.ffn_w_in + (size_t)1 * 1024 * 5632; c.dst = (bf16_t*)(ws + W_FI1); c.K = 1024; c.N = 5632; c.mode = 1; }
    else if (j == 9) { c.src = p.ffn_w_out + (size_t)1 * 2816 * 1024; c.dst = (bf16_t*)(ws + W_FO1); c.K = 2816; c.N = 1024; }
    else if (j == 10) { c.src = p.na_w_qkv; c.dst = (bf16_t*)(ws + W_QKV); c.K = 1024; c.N = 3072; }
    else if (j == 11) { c.src = p.na_w_out; c.dst = (bf16_t*)(ws + W_NOUT); c.K = 1024; c.N = 1024; }
    else if (j == 12) { c.src = p.ffn_w_in + (size_t)2 * 1024 * 5632; c.dst = (bf16_t*)(ws + W_FI2); c.K = 1024; c.N = 5632; c.mode = 1; }
    else if (j == 13) { c.src = p.ffn_w_out + (size_t)2 * 2816 * 1024; c.dst = (bf16_t*)(ws + W_FO2); c.K = 2816; c.N = 1024; }
    else if (j < 18) { const int g = j - 14; c.src = p.pool_w + 262144 + (size_t)g * 65536; c.dst = (bf16_t*)(ws + W_POOL1) + (size_t)g * 65536; c.K = 256; c.N = 256; }
    else if (j == 18) { c.src = p.ffn_w_in + (size_t)3 * 1024 * 5632; c.dst = (bf16_t*)(ws + W_FI3); c.K = 1024; c.N = 5632; c.mode = 1; }
    else { c.src = p.ffn_w_out + (size_t)3 * 2816 * 1024; c.dst = (bf16_t*)(ws + W_FO3); c.K = 2816; c.N = 1024; }
}
__device__ __forceinline__ bool conv_locate(const Params& p, int j0, int j1, int g, ConvJob& c, int& t) {
    for (int j = j0; j < j1; ++j) { get_conv_job(p, j, c); const int nt = (c.K >> 6) * (c.N >> 7); if (g < nt) { t = g; return true; } g -= nt; }
    return false;
}
__device__ __forceinline__ void conv_load(const ConvJob& c, int tile, f32x4 (&v)[4], const int TID) {
    const int ntn = c.N >> 7; const int k0 = (tile / ntn) * 64, n0 = (tile % ntn) * 128;
#pragma unroll
    for (int it = 0; it < 4; ++it) { const int idx = TID + it * 512; const int kk = idx >> 5, n4 = idx & 31;
        v[it] = *(const f32x4*)(c.src + (size_t)(k0 + kk) * c.N + n0 + n4 * 4); }
}
__device__ void conv_jobs(const Params& p, int j0, int j1, LAS unsigned char* ldsb, const int TID, const int BIDe, const int GRDe) {
    LAS float* lds = (LAS float*)ldsb;
    ConvJob c, cn; int t = 0, tn = 0; f32x4 v[4], vn[4];
    int g = BIDe;
    bool have = conv_locate(p, j0, j1, g, c, t);
    if (have) conv_load(c, t, v, TID);
    while (have) {
        const bool hn = conv_locate(p, j0, j1, g + GRDe, cn, tn);
        if (hn) conv_load(cn, tn, vn, TID);
        const int ntn = c.N >> 7; const int k0 = (t / ntn) * 64, n0 = (t % ntn) * 128;
#pragma unroll
        for (int it = 0; it < 4; ++it) { const int idx = TID + it * 512; const int kk = idx >> 5, n4 = idx & 31; *(LAS f32x4*)(lds + kk * 132 + n4 * 4) = v[it]; }
        __syncthreads();
#pragma unroll
        for (int it = 0; it < 2; ++it) { const int idx = TID + it * 512; const int n = idx & 127, kg = idx >> 7;
            float x[8];
#pragma unroll
            for (int i = 0; i < 8; ++i) x[i] = lds[(kg * 8 + i) * 132 + n];
            u32x4 w; w.x = cvt_pk_bf16(x[0], x[1]); w.y = cvt_pk_bf16(x[2], x[3]); w.z = cvt_pk_bf16(x[4], x[5]); w.w = cvt_pk_bf16(x[6], x[7]);
            const int row = map_row(n0 + n, c.mode);
            *(u32x4*)(c.dst + (size_t)row * c.K + k0 + kg * 8) = w; }
        __syncthreads();
        g += GRDe; have = hn; c = cn; t = tn;
#pragma unroll
        for (int it = 0; it < 4; ++it) v[it] = vn[it];
    }
}
__device__ void mod_gemv(const Params& p, LAS unsigned char* lds, int l0, int l1, const int TID, const int BIDe, const int GRDe) {
    LAS float* s = (LAS float*)lds;
    LAS float* red = (LAS float*)(lds + 9 * 1024 * 4);
    const int tid = TID; const int nitems = (l1 - l0) * 96;
    if (BIDe >= nitems) return;
    for (int i = tid; i < 9 * 1024; i += 512) { const int j = i >> 10, k = i & 1023; const float v = j < 8 ? p.c[j * 1024 + k] : p.c_ctx[k]; s[i] = silu_f(v); }
    __syncthreads();
    float* MOD = (float*)(p.ws + WS_MOD);
    for (int item = BIDe; item < nitems; item += GRDe) {
        const int l = l0 + item / 96, n0 = (item % 96) * 64; const int pp = tid >> 4, c4 = (tid & 15) * 4;
        f32x4 acc[9];
#pragma unroll
        for (int j = 0; j < 9; ++j) acc[j] = (f32x4){0.f, 0.f, 0.f, 0.f};
        const float* w = p.mod_w + (size_t)l * 1024 * 6144 + n0 + c4;
#pragma unroll 8
        for (int k = pp * 32; k < pp * 32 + 32; ++k) { const f32x4 wv = *(const f32x4*)(w + (size_t)k * 6144);
#pragma unroll
            for (int j = 0; j < 9; ++j) acc[j] = acc[j] + wv * s[j * 1024 + k]; }
#pragma unroll
        for (int j = 0; j < 9; ++j) *(LAS f32x4*)(red + (pp * 9 + j) * 64 + c4) = acc[j];
        __syncthreads();
        for (int o = tid; o < 9 * 64; o += 512) { const int j = o >> 6, col = o & 63; float v = p.mod_b[l * 6144 + n0 + col];
#pragma unroll 8
            for (int q = 0; q < 32; ++q) v += red[(q * 9 + j) * 64 + col];
            MOD[(size_t)(l * 9 + j) * 6144 + n0 + col] = v; }
        __syncthreads();
    }
}
__device__ void lb_compute(const Params& p, const int TID, const int BID, const int GRD) {
    float* LB = (float*)(p.ws + WS_LB);
    for (int i = BID * 512 + TID; i < 2048; i += GRD * 512) { const int dir = i >> 10, cidx = i & 1023;
        float l[4], mx = -1e30f;
#pragma unroll
        for (int j = 0; j < 4; ++j) { l[j] = p.hgrn_lb[(dir * 4 + j) * 1024 + cidx]; mx = fmaxf(mx, l[j]); }
        float sum = 0.f, e1 = 0.f;
#pragma unroll
        for (int j = 0; j < 4; ++j) { const float e = __expf(l[j] - mx); sum += e; if (j == 1) e1 = e; }
        LB[i] = e1 / sum; }
}

__device__ void ln_pass(float* xl, float* xc, int rows, const float* g, const float* bta, const float* modsc, const float* modsh, bf16_t* hb, const int TID, const int BID, const int GRD) {
    const int wave = TID >> 6, lane = TID & 63;
    const int stride = GRD * 8;
    for (int row0 = BID * 8 + wave; row0 < rows; row0 += 2 * stride) {
        const int row1 = row0 + stride; const bool has1 = row1 < rows;
        float* xp0 = row0 < TL ? xl + (size_t)row0 * D : xc + (size_t)(row0 - TL) * D;
        float* xp1 = has1 ? (row1 < TL ? xl + (size_t)row1 * D : xc + (size_t)(row1 - TL) * D) : xp0;
        f32x4 v0[4], v1[4]; float s0 = 0.f, s1 = 0.f;
#pragma unroll
        for (int i = 0; i < 4; ++i) { v0[i] = *(const f32x4*)(xp0 + lane * 4 + i * 256); v1[i] = *(const f32x4*)(xp1 + lane * 4 + i * 256); }
#pragma unroll
        for (int i = 0; i < 4; ++i) { s0 += v0[i][0] + v0[i][1] + v0[i][2] + v0[i][3]; s1 += v1[i][0] + v1[i][1] + v1[i][2] + v1[i][3]; }
        const float mean0 = wave_sum(s0) * (1.f / 1024.f), mean1 = wave_sum(s1) * (1.f / 1024.f);
        float q0 = 0.f, q1 = 0.f;
#pragma unroll
        for (int i = 0; i < 4; ++i) { v0[i] = v0[i] - mean0; v1[i] = v1[i] - mean1;
            q0 += v0[i][0] * v0[i][0] + v0[i][1] * v0[i][1] + v0[i][2] * v0[i][2] + v0[i][3] * v0[i][3];
            q1 += v1[i][0] * v1[i][0] + v1[i][1] * v1[i][1] + v1[i][2] * v1[i][2] + v1[i][3] * v1[i][3]; }
        const float rstd0 = rsqrtf(wave_sum(q0) * (1.f / 1024.f) + LN_EPS), rstd1 = rsqrtf(wave_sum(q1) * (1.f / 1024.f) + LN_EPS);
        const int mr0 = row0 < TL ? (row0 >> 11) : 8, mr1 = row1 < TL ? (row1 >> 11) : 8;
#pragma unroll
        for (int i = 0; i < 4; ++i) { const int c = lane * 4 + i * 256;
            const f32x4 gv = *(const f32x4*)(g + c), bv = *(const f32x4*)(bta + c);
            const f32x4 y0 = v0[i] * rstd0 * gv + bv, y1 = v1[i] * rstd1 * gv + bv;
            *(f32x4*)(xp0 + c) = y0;
            if (has1) *(f32x4*)(xp1 + c) = y1;
            if (hb) { const f32x4 sc0 = *(const f32x4*)(modsc + mr0 * 6144 + c), sh0 = *(const f32x4*)(modsh + mr0 * 6144 + c);
                const f32x4 h0 = y0 * (sc0 + 1.f) + sh0; u32x2 w; w.x = cvt_pk_bf16(h0[0], h0[1]); w.y = cvt_pk_bf16(h0[2], h0[3]);
                *(u32x2*)(hb + (size_t)row0 * D + c) = w;
                if (has1) { const f32x4 sc1 = *(const f32x4*)(modsc + mr1 * 6144 + c), sh1 = *(const f32x4*)(modsh + mr1 * 6144 + c);
                    const f32x4 h1 = y1 * (sc1 + 1.f) + sh1; u32x2 w1; w1.x = cvt_pk_bf16(h1[0], h1[1]); w1.y = cvt_pk_bf16(h1[2], h1[3]);
                    *(u32x2*)(hb + (size_t)row1 * D + c) = w1; } } }
    }
}
__device__ void pool_prep(const float* srcL, const float* srcC, int rows, const float* modsc, bf16_t* out, const int TID, const int BID, const int GRD) {
    const int rsh = (rows == TL) ? 5 : 4, runlen = 1 << rsh;
    const int nitems = (rows >> rsh) * 256;
    for (int it = BID * 512 + TID; it < nitems; it += GRD * 512) {
        const int run = it >> 8, c = (it & 255) * 4; const int g = c >> 8; const int w = 2 << g, lo = w >> 1, hi = w - 1 - lo;
        const int row0 = run << rsh; const bool lat = row0 < TL; const int t0 = lat ? (row0 & 2047) : ((row0 - TL) & 255); const int L = lat ? SEQ : CTXL;
        const float* base = (lat ? srcL + (size_t)(row0 - t0) * D : srcC + (size_t)(row0 - TL - t0) * D) + c;
        const int mr = lat ? (row0 >> 11) : 8;
        const f32x4 sc1 = *(const f32x4*)(modsc + mr * 6144 + c) + 1.f;
        f32x4 acc = {0.f, 0.f, 0.f, 0.f};
        int s0 = t0 - lo < 0 ? 0 : t0 - lo, e0 = t0 + hi + 1 > L ? L : t0 + hi + 1;
        for (int tt = s0; tt < e0; ++tt) acc = acc + *(const f32x4*)(base + (size_t)tt * D);
        bf16_t* op = out + (size_t)row0 * D + c;
#pragma unroll 4
        for (int i = 0; i < runlen; ++i) { const int t = t0 + i;
            const f32x4 xv = *(const f32x4*)(base + (size_t)t * D);
            const float inv = 1.f / (float)(e0 - s0);
            const f32x4 r = (acc * inv - xv) * sc1;
            u32x2 wv; wv.x = cvt_pk_bf16(r[0], r[1]); wv.y = cvt_pk_bf16(r[2], r[3]);
            *(u32x2*)(op + (size_t)i * D) = wv;
            if (t + 1 + hi < L) { acc = acc + *(const f32x4*)(base + (size_t)(t + 1 + hi) * D); ++e0; }
            if (t + 1 - lo > 0) { acc = acc - *(const f32x4*)(base + (size_t)(t - lo) * D); ++s0; } }
    }
}

__device__ void scan_phase(const Params& p, LAS unsigned char* lds, const int TID, const int BID, const int GRD) {
    constexpr int QP = 0, KP = 17408, KPT = 34816, VTO = 53248, AM = 62464, STO = 71680, GS = 89088, DEC = 91136;
    const bf16_t* P = (const bf16_t*)(p.ws + WS_BIG); const bf16_t* VTg = (const bf16_t*)(p.ws + WS_VT);
    const int tid = TID, wave = tid >> 6, lane = tid & 63, l15 = lane & 15, quad = lane >> 4;
    LAS float* gs = (LAS float*)(lds + GS); LAS float* dec = (LAS float*)(lds + DEC);
    for (int task = BID; task < 256; task += GRD) {
        const int eh = task & 1, dir = (task >> 1) & 1, h = (task >> 2) & 7, b = task >> 5;
        bf16_t* Og = (bf16_t*)(p.ws + (dir ? WS_OB : WS_HB));
        const int d = tid & 127, tg = tid >> 7;
        const int zoff = (dir ? 2048 : 1024) + h * 128 + d, qoff = h * 128 + d;
        f32x4 Sacc[4];
#pragma unroll
        for (int i = 0; i < 4; ++i) Sacc[i] = (f32x4){0.f, 0.f, 0.f, 0.f};
#define SCAN_ROW0(st_) ((st_) < 4 ? TL + b * CTXL + (dir ? 3 - (st_) : (st_)) * 64 : b * SEQ + (dir ? 31 - ((st_) - 4) : (st_) - 4) * 64)
#define SCAN_LOAD(st_) do { const int r0_ = SCAN_ROW0(st_); const bf16_t* Pr_ = P + (size_t)(r0_ + tg * 16) * 4096; \
            _Pragma("unroll") for (int i = 0; i < 16; ++i) { zr[i] = Pr_[(size_t)i * 4096 + zoff]; qr[i] = Pr_[(size_t)i * 4096 + qoff]; } \
            vtr = *(const u32x4*)(VTg + (size_t)(h * 128 + eh * 64 + (tid >> 3)) * TT + r0_ + (tid & 7) * 8); } while (0)
        bf16_t zr[16], qr[16]; u32x4 vtr;
        SCAN_LOAD(0);
        for (int step = 0; step < 36; ++step) {
            const int row0 = SCAN_ROW0(step);
            float lf[16], kk[16], qv[16];
#pragma unroll
            for (int i = 0; i < 16; ++i) { lf[i] = bf2f(zr[i]); kk[i] = 1.f - __builtin_amdgcn_exp2f(lf[i]); qv[i] = bf2f(qr[i]); }
            { const int e = tid >> 3, s8 = tid & 7; *(LAS u32x4*)(lds + VTO + e * 144 + s8 * 16) = vtr; }
            if (step + 1 < 36) SCAN_LOAD(step + 1);
            float run = 0.f;
            if (dir == 0) {
#pragma unroll
                for (int i = 0; i < 16; ++i) { run += lf[i]; lf[i] = run; }
            } else {
#pragma unroll
                for (int i = 15; i >= 0; --i) { run += lf[i]; lf[i] = run; }
            }
            gs[tg * 128 + d] = run;
            __syncthreads();
            const float g0 = gs[d], g1 = gs[128 + d], g2 = gs[256 + d], g3 = gs[384 + d];
            const float tot = g0 + g1 + g2 + g3;
            float off, cref;
            if (dir == 0) { off = (tg > 0 ? g0 : 0.f) + (tg > 1 ? g1 : 0.f) + (tg > 2 ? g2 : 0.f); cref = g0 + g1; }
            else { off = (tg < 3 ? g3 : 0.f) + (tg < 2 ? g2 : 0.f) + (tg < 1 ? g1 : 0.f); cref = g3 + g2; }
            if (tg == 0) { dec[d] = __builtin_amdgcn_exp2f(tot); dec[128 + d] = __builtin_amdgcn_exp2f(tot - cref); dec[256 + d] = __builtin_amdgcn_exp2f(cref); }
            unsigned kp[8];
#pragma unroll
            for (int i = 0; i < 16; i += 2) {
                const float b0 = off + lf[i] - cref, b1 = off + lf[i + 1] - cref;
                const float q0 = qv[i] * __builtin_amdgcn_exp2f(b0), q1 = qv[i + 1] * __builtin_amdgcn_exp2f(b1), k0 = kk[i] * __builtin_amdgcn_exp2f(-b0), k1 = kk[i + 1] * __builtin_amdgcn_exp2f(-b1);
                const int t0 = tg * 16 + i;
                *(LAS bf16_t*)(lds + QP + t0 * 272 + d * 2) = f2bf(q0); *(LAS bf16_t*)(lds + QP + (t0 + 1) * 272 + d * 2) = f2bf(q1);
                const unsigned kpk = cvt_pk_bf16(k0, k1); kp[i >> 1] = kpk;
                *(LAS bf16_t*)(lds + KP + t0 * 272 + d * 2) = (bf16_t)(kpk & 0xffffu); *(LAS bf16_t*)(lds + KP + (t0 + 1) * 272 + d * 2) = (bf16_t)(kpk >> 16); }
            *(LAS u32x4*)(lds + KPT + d * 144 + tg * 32) = (u32x4){kp[0], kp[1], kp[2], kp[3]};
            *(LAS u32x4*)(lds + KPT + d * 144 + tg * 32 + 16) = (u32x4){kp[4], kp[5], kp[6], kp[7]};
            __syncthreads();
            { const int dd = wave * 16 + l15; const float dm = dec[256 + dd];
#pragma unroll
              for (int em = 0; em < 4; ++em)
#pragma unroll
                  for (int j = 0; j < 4; ++j) *(LAS bf16_t*)(lds + STO + (em * 16 + quad * 4 + j) * 272 + dd * 2) = f2bf(Sacc[em][j] * dm); }
            const int tm = wave >> 1;
#pragma unroll
            for (int u = 0; u < 2; ++u) { const int sn = (wave & 1) * 2 + u; f32x4 a = {0.f, 0.f, 0.f, 0.f};
#pragma unroll
                for (int k4 = 0; k4 < 4; ++k4) { const bf16x8 af = *(const LAS bf16x8*)(lds + QP + (tm * 16 + l15) * 272 + k4 * 64 + quad * 16);
                    const bf16x8 bfr = *(const LAS bf16x8*)(lds + KP + (sn * 16 + l15) * 272 + k4 * 64 + quad * 16);
                    a = __builtin_amdgcn_mfma_f32_16x16x32_bf16(af, bfr, a, 0, 0, 0); }
#pragma unroll
                for (int j = 0; j < 4; ++j) { const int t = tm * 16 + quad * 4 + j, s = sn * 16 + l15; const bool keep = dir ? (s >= t) : (s <= t);
                    *(LAS bf16_t*)(lds + AM + t * 144 + s * 2) = f2bf(keep ? a[j] : 0.f); } }
            __syncthreads();
#pragma unroll
            for (int u = 0; u < 2; ++u) { const int en = (wave & 1) * 2 + u; f32x4 o = {0.f, 0.f, 0.f, 0.f};
#pragma unroll
                for (int k2 = 0; k2 < 2; ++k2) { const bf16x8 af = *(const LAS bf16x8*)(lds + AM + (tm * 16 + l15) * 144 + k2 * 64 + quad * 16);
                    const bf16x8 bfr = *(const LAS bf16x8*)(lds + VTO + (en * 16 + l15) * 144 + k2 * 64 + quad * 16);
                    o = __builtin_amdgcn_mfma_f32_16x16x32_bf16(af, bfr, o, 0, 0, 0); }
#pragma unroll
                for (int k4 = 0; k4 < 4; ++k4) { const bf16x8 af = *(const LAS bf16x8*)(lds + QP + (tm * 16 + l15) * 272 + k4 * 64 + quad * 16);
                    const bf16x8 bfr = *(const LAS bf16x8*)(lds + STO + (en * 16 + l15) * 272 + k4 * 64 + quad * 16);
                    o = __builtin_amdgcn_mfma_f32_16x16x32_bf16(af, bfr, o, 0, 0, 0); }
#pragma unroll
                for (int j = 0; j < 4; ++j) { const int t = tm * 16 + quad * 4 + j, e = en * 16 + l15;
                    Og[(size_t)(row0 + t) * D + h * 128 + eh * 64 + e] = f2bf(o[j]); } }
            { const int dd = wave * 16 + l15; const float de = dec[dd], dk = dec[128 + dd];
#pragma unroll
              for (int em = 0; em < 4; ++em) { f32x4 kv = {0.f, 0.f, 0.f, 0.f};
#pragma unroll
                  for (int k2 = 0; k2 < 2; ++k2) { const bf16x8 af = *(const LAS bf16x8*)(lds + VTO + (em * 16 + l15) * 144 + k2 * 64 + quad * 16);
                      const bf16x8 bfr = *(const LAS bf16x8*)(lds + KPT + (wave * 16 + l15) * 144 + k2 * 64 + quad * 16);
                      kv = __builtin_amdgcn_mfma_f32_16x16x32_bf16(af, bfr, kv, 0, 0, 0); }
                  Sacc[em] = Sacc[em] * de + kv * dk; } }
            __syncthreads();
        }
    }
}
__device__ void hgrn_readout(const Params& p, const int TID, const int BID, const int GRD) {
    bf16_t* OF = (bf16_t*)(p.ws + WS_HB); const bf16_t* OBp = (const bf16_t*)(p.ws + WS_OB); const bf16_t* P = (const bf16_t*)(p.ws + WS_BIG);
    const int wave = TID >> 6, lane = TID & 63;
    for (int row = BID * 8 + wave; row < TT; row += GRD * 8) {
        const int c0 = lane * 16;
        float o[16], gg[16]; float ss = 0.f;
#pragma unroll
        for (int hf = 0; hf < 2; ++hf) { const u32x4 a = *(const u32x4*)(OF + (size_t)row * D + c0 + hf * 8), bb = *(const u32x4*)(OBp + (size_t)row * D + c0 + hf * 8);
            const u32x4 gv = *(const u32x4*)(P + (size_t)row * 4096 + 3072 + c0 + hf * 8);
#pragma unroll
            for (int i = 0; i < 4; ++i) { const float v0 = bf2f(a[i] & 0xffffu) + bf2f(bb[i] & 0xffffu), v1 = bf2f(a[i] >> 16) + bf2f(bb[i] >> 16);
                o[hf * 8 + i * 2] = v0; o[hf * 8 + i * 2 + 1] = v1; ss += v0 * v0 + v1 * v1;
                gg[hf * 8 + i * 2] = bf2f(gv[i] & 0xffffu); gg[hf * 8 + i * 2 + 1] = bf2f(gv[i] >> 16); } }
        ss += __shfl_xor(ss, 1, 64); ss += __shfl_xor(ss, 2, 64); ss += __shfl_xor(ss, 4, 64);
        const float r = rsqrtf(ss * (1.f / 128.f) + RMS_EPS);
        unsigned w[8];
#pragma unroll
        for (int i = 0; i < 8; ++i) { const float nw0 = p.hgrn_norm_w[c0 + 2 * i], nw1 = p.hgrn_norm_w[c0 + 2 * i + 1];
            w[i] = cvt_pk_bf16(o[2 * i] * r * nw0 * gg[2 * i], o[2 * i + 1] * r * nw1 * gg[2 * i + 1]); }
        *(u32x4*)(OF + (size_t)row * D + c0) = (u32x4){w[0], w[1], w[2], w[3]};
        *(u32x4*)(OF + (size_t)row * D + c0 + 8) = (u32x4){w[4], w[5], w[6], w[7]};
    }
}

__device__ void na_phase(const Params& p, LAS unsigned char* lds, const int TID, const int BID, const int GRD) {
    const bf16_t* QK = (const bf16_t*)(p.ws + WS_BIG); const bf16_t* VTg = (const bf16_t*)(p.ws + WS_VT2); bf16_t* O = (bf16_t*)(p.ws + WS_HB);
    const int wave = TID >> 6, lane = TID & 63, l15 = lane & 15, quad = lane >> 4;
    constexpr int KC = 2048, VC = 2048 + 36864;
    const LAS float* rpl = (const LAS float*)lds;
    const int u0 = (int)((long)BID * 2048 / GRD), u1 = (int)((long)(BID + 1) * 2048 / GRD);
    int bh_cached = -1;
    for (int u = u0; u < u1; ++u) {
        const int bh = u >> 4, rp = u & 15, b = bh >> 4, h = bh & 15;
        if (bh != bh_cached) {
            __syncthreads();
            for (int i = TID; i < 465; i += 512) ((LAS float*)lds)[i] = p.na_rpb[h * 465 + i] * 1.44269504f;
#pragma unroll
            for (int it = 0; it < 4; ++it) { const int idx = TID + it * 512; const int key = idx >> 3, seg = idx & 7;
                *(LAS u32x4*)(lds + KC + key * 144 + seg * 16) = *(const u32x4*)(QK + (size_t)(TL + b * CTXL + key) * 2048 + 1024 + h * 64 + seg * 8); }
#pragma unroll
            for (int it = 0; it < 4; ++it) { const int idx = TID + it * 512; const int e = idx >> 5, seg = idx & 31;
                *(LAS u32x4*)(lds + VC + e * 528 + seg * 16) = *(const u32x4*)(VTg + (size_t)(h * 64 + e) * TT + TL + b * CTXL + seg * 8); }
            __syncthreads();
            bh_cached = bh;
        }
        const int jb = wave & 3, r = rp * 2 + (wave >> 2);
        const int qrow = b * SEQ + r * 64 + jb * 16 + l15;
        const bf16x8 qf0 = *(const bf16x8*)(QK + (size_t)qrow * 2048 + h * 64 + quad * 8), qf1 = *(const bf16x8*)(QK + (size_t)qrow * 2048 + h * 64 + 32 + quad * 8);
        const int rs = r - 4 < 0 ? 0 : (r - 4 > 24 ? 24 : r - 4);
        const int bs = jb * 16 - 8 < 0 ? 0 : (jb * 16 - 8 > 32 ? 32 : jb * 16 - 8);
        const int qc = jb * 16 + l15; const int wst = qc - 8 < 0 ? 0 : (qc - 8 > 48 ? 48 : qc - 8);
        int dcv[8]; unsigned okm = 0u;
#pragma unroll
        for (int t = 0; t < 2; ++t)
#pragma unroll
            for (int j = 0; j < 4; ++j) { const int kc = bs + quad * 8 + 4 * t + j; const bool ok = kc >= wst && kc < wst + 16; int dc = kc - qc + 15; dc = dc < 0 ? 0 : (dc > 30 ? 30 : dc); dcv[t * 4 + j] = dc; okm |= ok ? (1u << (t * 4 + j)) : 0u; }
        float m = -1e30f, l = 0.f;
        f32x4 o[4];
#pragma unroll
        for (int i = 0; i < 4; ++i) o[i] = (f32x4){0.f, 0.f, 0.f, 0.f};
        const bf16_t* Kb = QK + 1024 + h * 64 + quad * 8;
        const bf16_t* Vb = VTg + (size_t)(h * 64 + l15) * TT + quad * 8;
#define NA_BASE(grp) ((grp) >= 8 ? b * SEQ + (rs + (grp) - 8) * 64 + bs : TL + b * CTXL + (grp) * 32)
#define NA_LOAD_CTX(grp, KF, VF) do { \
            _Pragma("unroll") for (int t = 0; t < 2; ++t) { const int kb_ = KC + ((grp) * 32 + 8 * (l15 >> 2) + 4 * t + (l15 & 3)) * 144 + quad * 16; KF[t][0] = *(const LAS bf16x8*)(lds + kb_); KF[t][1] = *(const LAS bf16x8*)(lds + kb_ + 64); } \
            _Pragma("unroll") for (int et = 0; et < 4; ++et) VF[et] = *(const LAS bf16x8*)(lds + VC + (et * 16 + l15) * 528 + ((grp) * 32 + quad * 8) * 2); } while (0)
#define NA_LOAD(grp, KF, VF) do { const int _base = NA_BASE(grp); \
            _Pragma("unroll") for (int t = 0; t < 2; ++t) { const bf16_t* kp_ = Kb + (size_t)(_base + 8 * (l15 >> 2) + 4 * t + (l15 & 3)) * 2048; KF[t][0] = *(const bf16x8*)kp_; KF[t][1] = *(const bf16x8*)(kp_ + 32); } \
            _Pragma("unroll") for (int et = 0; et < 4; ++et) { const bf16_t* vp_ = Vb + (size_t)(et * 16) * TT + _base; VF[et] = *(const bf16x8*)vp_; } } while (0)
#define NA_COMPUTE(grp, KF, VF) do { const bool loc = (grp) >= 8; const int a = (grp) - 8; \
            f32x4 st[2]; \
            _Pragma("unroll") for (int t = 0; t < 2; ++t) { f32x4 s_ = {0.f, 0.f, 0.f, 0.f}; \
                s_ = __builtin_amdgcn_mfma_f32_16x16x32_bf16(KF[t][0], qf0, s_, 0, 0, 0); \
                s_ = __builtin_amdgcn_mfma_f32_16x16x32_bf16(KF[t][1], qf1, s_, 0, 0, 0); st[t] = s_ * (0.125f * 1.44269504f); } \
            if (loc) { const LAS float* rp = rpl + (rs + a - r + 7) * 31; \
                _Pragma("unroll") for (int t = 0; t < 2; ++t) _Pragma("unroll") for (int j = 0; j < 4; ++j) st[t][j] = ((okm >> (t * 4 + j)) & 1u) ? st[t][j] + rp[dcv[t * 4 + j]] : -1e30f; } \
            float mx = fmaxf(fmaxf(fmaxf(st[0][0], st[0][1]), fmaxf(st[0][2], st[0][3])), fmaxf(fmaxf(st[1][0], st[1][1]), fmaxf(st[1][2], st[1][3]))); \
            mx = fmaxf(mx, __shfl_xor(mx, 16, 64)); mx = fmaxf(mx, __shfl_xor(mx, 32, 64)); \
            const float mn = fmaxf(m, mx); \
            if (__builtin_amdgcn_ballot_w64(mn != m) != 0ull) { const float corr = __builtin_amdgcn_exp2f(m - mn); l *= corr; \
                _Pragma("unroll") for (int et = 0; et < 4; ++et) o[et] = o[et] * corr; } \
            m = mn; \
            float pv[8]; float ps = 0.f; \
            _Pragma("unroll") for (int t = 0; t < 2; ++t) _Pragma("unroll") for (int j = 0; j < 4; ++j) { const float e_ = __builtin_amdgcn_exp2f(st[t][j] - mn); pv[t * 4 + j] = e_; ps += e_; } \
            l += ps; \
            union { bf16x8 v; unsigned u[4]; } pf; \
            pf.u[0] = cvt_pk_bf16(pv[0], pv[1]); pf.u[1] = cvt_pk_bf16(pv[2], pv[3]); pf.u[2] = cvt_pk_bf16(pv[4], pv[5]); pf.u[3] = cvt_pk_bf16(pv[6], pv[7]); \
            _Pragma("unroll") for (int et = 0; et < 4; ++et) o[et] = __builtin_amdgcn_mfma_f32_16x16x32_bf16(VF[et], pf.v, o[et], 0, 0, 0); } while (0)
        bf16x8 kA[2][2], kB[2][2], kC[2][2]; bf16x8 vA[4], vB[4], vC[4];
        NA_LOAD(8, kA, vA); NA_LOAD(9, kB, vB);
#pragma unroll 1
        for (int g = 0; g < 8; ++g) { NA_LOAD_CTX(g, kC, vC); NA_COMPUTE(g, kC, vC); }
        NA_LOAD(10, kC, vC);
#pragma unroll 1
        for (int g = 8; g < 16; g += 3) {
            NA_COMPUTE(g, kA, vA); if (g + 3 < 16) NA_LOAD(g + 3, kA, vA);
            if (g + 1 < 16) { NA_COMPUTE(g + 1, kB, vB); if (g + 4 < 16) NA_LOAD(g + 4, kB, vB); }
            if (g + 2 < 16) { NA_COMPUTE(g + 2, kC, vC); if (g + 5 < 16) NA_LOAD(g + 5, kC, vC); }
        }
#undef NA_BASE
#undef NA_LOAD
#undef NA_LOAD_CTX
#undef NA_COMPUTE
        l += __shfl_xor(l, 16, 64); l += __shfl_xor(l, 32, 64);
        const float inv = 1.f / l;
#pragma unroll
        for (int et = 0; et < 4; ++et) { u32x2 w; w.x = cvt_pk_bf16(o[et][0] * inv, o[et][1] * inv); w.y = cvt_pk_bf16(o[et][2] * inv, o[et][3] * inv);
            *(u32x2*)(O + (size_t)qrow * D + h * 64 + et * 16 + quad * 4) = w; }
    }
}

#define XB_TMO      128
#define XB_XCNT(j)  (256  + 64 * (j))
#define XB_XSUB(j)  (1280 + 64 * (j))
#define XB_XGEN(j)  (2304 + 64 * (j))
#define XB_TOP      3328
#define XB_TOPGEN   3392
#define XCD_BAR_WORDS 3456
#define XB_SPIN_CAP (1u << 18)
__device__ __forceinline__ unsigned xb_ld(unsigned* p)              { return __hip_atomic_load(p, __ATOMIC_RELAXED, __HIP_MEMORY_SCOPE_AGENT); }
__device__ __forceinline__ unsigned xb_add(unsigned* p, unsigned v) { return __hip_atomic_fetch_add(p, v, __ATOMIC_RELAXED, __HIP_MEMORY_SCOPE_AGENT); }
__device__ __forceinline__ unsigned xb_xcc_id() { return (unsigned)__builtin_amdgcn_s_getreg((3 << 11) | 20) & 0xFu; }
#define XB_SPIN(cond, bar) do { unsigned _sp = 0; while (cond) { __builtin_amdgcn_s_sleep(1); \
    if ((++_sp & 255u) == 0u) { if (xb_ld(&(bar)[XB_TMO])) break; if (_sp > XB_SPIN_CAP) { atomicAdd(&(bar)[XB_TMO], 1u); break; } } } } while (0)
struct XcdBarrier { unsigned* bar; unsigned x; volatile LAS unsigned* st; };
__device__ __forceinline__ XcdBarrier xcd_barrier_post(unsigned* bar, volatile LAS unsigned* st) {
    XcdBarrier b; b.bar = bar; b.x = xb_xcc_id(); b.st = st;
    if (threadIdx.x == 0) (void)xb_add(&bar[XB_XCNT(b.x)], 1u);
    return b;
}
__device__ __forceinline__ void xcd_barrier_complete(unsigned* bar, unsigned x, unsigned& nloc, unsigned& nx) {
    const unsigned G = gridDim.x * gridDim.y * gridDim.z;
    unsigned sum, cnt, mine, sp = 0u;
    for (;;) {
        sum = 0u; cnt = 0u; mine = 0u;
#pragma unroll
        for (unsigned j = 0; j < 16; ++j) { const unsigned c = xb_ld(&bar[XB_XCNT(j)]); sum += c; cnt += (c > 0u) ? 1u : 0u; mine = (j == x) ? c : mine; }
        if (sum == G) break;
        __builtin_amdgcn_s_sleep(1);
        if ((++sp & 255u) == 0u) { if (xb_ld(&bar[XB_TMO])) break; if (sp > XB_SPIN_CAP) { atomicAdd(&bar[XB_TMO], 1u); break; } }
    }
    nloc = mine > 0u ? mine : 1u; nx = cnt > 0u ? cnt : 1u;
}
__device__ __forceinline__ void xcd_barrier(const XcdBarrier& b) {
    asm volatile("s_waitcnt vmcnt(0)" ::: "memory");
    __syncthreads();
    if (threadIdx.x == 0) {
        unsigned* bar = b.bar;
        __builtin_amdgcn_s_waitcnt(0);
        unsigned nloc = b.st[0], nx = b.st[1];
        if (nloc == 0u) { xcd_barrier_complete(bar, b.x, nloc, nx); b.st[0] = nloc; b.st[1] = nx; }
        const unsigned old = xb_add(&bar[XB_XSUB(b.x)], 1u);
        const unsigned gen = old / nloc;
        if (old + 1u == (gen + 1u) * nloc) {
            __builtin_amdgcn_fence(__ATOMIC_RELEASE, "agent");
            asm volatile("s_waitcnt vmcnt(0)" ::: "memory");
            const unsigned og = xb_add(&bar[XB_TOP], 1u);
            const unsigned tg = og / nx;
            if (og + 1u == (tg + 1u) * nx) xb_add(&bar[XB_TOPGEN], 1u);
            else XB_SPIN(xb_ld(&bar[XB_TOPGEN]) == tg, bar);
            __builtin_amdgcn_fence(__ATOMIC_ACQUIRE, "agent");
            xb_add(&bar[XB_XGEN(b.x)], 1u);
            asm volatile("s_waitcnt vmcnt(0)" ::: "memory");
        } else {
            XB_SPIN(xb_ld(&bar[XB_XGEN(b.x)]) == gen, bar);
            __builtin_amdgcn_fence(__ATOMIC_ACQUIRE, "agent");
            asm volatile("s_waitcnt vmcnt(0)" ::: "memory");
        }
    }
    __syncthreads();
}

enum { OP_PRO = 0, OP_POOLPREP, OP_GEMM_RESID, OP_GEMM_BF16, OP_SCAN, OP_READOUT, OP_NA, OP_LN1, OP_FFN1, OP_LN2 };
__global__ void __launch_bounds__(512, 2) mega(Params p, int ph_lo, int ph_hi) {
    extern __shared__ __attribute__((aligned(16))) unsigned char lds_raw[];
    LAS unsigned char* lds = (LAS unsigned char*)lds_raw;
    cg::grid_group grid = cg::this_grid();
    volatile LAS unsigned* bst = (volatile LAS unsigned*)(lds + 131072);
    if (threadIdx.x < 4) bst[threadIdx.x] = 0u;
    __syncthreads();
    XcdBarrier xbar = xcd_barrier_post((unsigned*)(p.ws + WS_BAR), bst);
    for (int ph = ph_lo; ph < ph_hi; ++ph) {
        int layer, idx, nmix;
        if (ph < 7) { layer = 0; idx = ph - 1; nmix = 2; } else if (ph < 15) { layer = 1; idx = ph - 7; nmix = 4; } else if (ph < 22) { layer = 2; idx = ph - 15; nmix = 3; } else { layer = 3; idx = ph - 22; nmix = 2; }
        int op; bool ffn2 = false;
        if (ph == 0) op = OP_PRO;
        else if (idx >= nmix) { const int k = idx - nmix; op = k == 0 ? OP_LN1 : k == 1 ? OP_FFN1 : k == 2 ? OP_GEMM_RESID : OP_LN2; ffn2 = (k == 2); }
        else if (layer == 0 || layer == 3) op = idx == 0 ? OP_POOLPREP : OP_GEMM_RESID;
        else if (layer == 1) op = idx == 0 ? OP_GEMM_BF16 : idx == 1 ? OP_SCAN : idx == 2 ? OP_READOUT : OP_GEMM_RESID;
        else op = idx == 0 ? OP_GEMM_BF16 : idx == 1 ? OP_NA : OP_GEMM_RESID;
        unsigned char* ws = p.ws; asm volatile("" : "+s"(ws));
        int G = gridDim.x, bid = blockIdx.x, tid = threadIdx.x; asm volatile("" : "+s"(G), "+s"(bid), "+v"(tid));
        const float* modl = (const float*)(ws + WS_MOD) + (size_t)layer * 9 * 6144;
        float* XC = (float*)(ws + WS_XC);
        const int Mrows = (layer >= 3) ? TL : TT;
        const int Mpost = (layer >= 2) ? TL : TT;
        if (op == OP_PRO) {
            conv_jobs(p, 0, 4, lds, tid, bid, G); __syncthreads(); mod_gemv(p, lds, 0, 1, tid, bid, G); lb_compute(p, tid, bid, G);
        } else if (op == OP_POOLPREP) {
            pool_prep(layer == 0 ? p.x : p.out, layer == 0 ? p.ctx : XC, Mrows, modl + 1024, (bf16_t*)(ws + WS_HB), tid, bid, G);
        } else if (op == OP_GEMM_RESID) {
            const void* A = ws + WS_HB; const void* Bt; int M = Mpost, K = 1024; unsigned lda = 2048u, ldb = 2048u, acol = 0u;
            const float* sL = p.out; const float* sC = XC; const float* gate = modl + 2048; const float* scale = nullptr;
            if (ffn2) { A = ws + WS_BIG; Bt = ws + (layer == 0 ? W_FO0 : layer == 1 ? W_FO1 : layer == 2 ? W_FO2 : W_FO3); K = FH; lda = 5632u; ldb = 5632u; gate = modl + 5120; }
            else if (layer == 0 || layer == 3) { Bt = ws + (layer == 0 ? W_POOL0 : W_POOL1); M = Mrows; K = 256; ldb = 512u; acol = 512u; scale = p.pool_scale + (layer == 0 ? 0 : 1024);
                if (layer == 0) { sL = p.x; sC = p.ctx; } }
            else if (layer == 1) { Bt = ws + W_HOUT; M = TT; }
            else { Bt = ws + W_NOUT; M = TL; }
            pg8::Sched S; S.init1(A, Bt, M, 1024, lda, ldb, acol, G, bid);
            pg8::EpiResid E{sL, sC, p.out, XC, gate, scale};
            pg8::gemm_phase<pg8::EpiResid>(lds, K, S, E, tid, bid, G);
            if (layer <= 1 && (ffn2 || layer == 0) && G > 64) { const int ja = layer == 0 ? (ffn2 ? 6 : 4) : 10, jb = layer == 0 ? (ffn2 ? 10 : 6) : 20;
                if (bid >= 32) { __syncthreads(); conv_jobs(p, ja, jb, lds, tid, bid - 32, G - 32);
                    if (layer == 0 && ffn2) { __syncthreads(); mod_gemv(p, lds, 1, 4, tid, bid - 32, G - 32); } } }
            else if (layer <= 1 && (ffn2 || layer == 0)) { const int ja = layer == 0 ? (ffn2 ? 6 : 4) : 10, jb = layer == 0 ? (ffn2 ? 10 : 6) : 20; __syncthreads(); conv_jobs(p, ja, jb, lds, tid, bid, G); if (layer == 0 && ffn2) { __syncthreads(); mod_gemv(p, lds, 1, 4, tid, bid, G); } }
        } else if (op == OP_GEMM_BF16) {
            const unsigned char* W = ws + (layer == 1 ? W_HIN : W_QKV); const int N0 = layer == 1 ? 4096 : 2048;
            pg8::Sched S; S.init1(ws + WS_HB, W, TT, N0, 2048u, 2048u, 0u, G, bid);
            S.add2(W + (size_t)N0 * 2048, ws + WS_HB, 1024, TT);
            pg8::EpiBf16P E{(bf16_t*)(ws + WS_BIG), (bf16_t*)(ws + (layer == 1 ? WS_VT : WS_VT2)), N0, TT, (const float*)(ws + WS_LB), layer == 1 ? 1 : 0};
            pg8::gemm_phase<pg8::EpiBf16P>(lds, 1024, S, E, tid, bid, G);
        } else if (op == OP_SCAN) {
            scan_phase(p, lds, tid, bid, G);
        } else if (op == OP_READOUT) {
            hgrn_readout(p, tid, bid, G);
        } else if (op == OP_NA) {
            na_phase(p, lds, tid, bid, G);
        } else if (op == OP_LN1) {
            ln_pass(p.out, XC, Mpost, p.ln_g + (layer * 2) * 1024, p.ln_b + (layer * 2) * 1024, modl + 4096, modl + 3072, (bf16_t*)(ws + WS_HB), tid, bid, G);
        } else if (op == OP_FFN1) {
            pg8::Sched S; S.init1(ws + WS_HB, ws + (layer == 0 ? W_FI0 : layer == 1 ? W_FI1 : layer == 2 ? W_FI2 : W_FI3), Mpost, 5632, 2048u, 2048u, 0u, G, bid);
            pg8::EpiSwiGLU E{(bf16_t*)(ws + WS_BIG)};
            pg8::gemm_phase<pg8::EpiSwiGLU>(lds, 1024, S, E, tid, bid, G);
        } else {
            const bool need_hb = (layer == 0 || layer == 1);
            const float* modn = (const float*)(ws + WS_MOD) + (size_t)(layer + 1 < 4 ? layer + 1 : 3) * 9 * 6144;
            ln_pass(p.out, XC, Mpost, p.ln_g + (layer * 2 + 1) * 1024, p.ln_b + (layer * 2 + 1) * 1024, modn + 1024, modn, need_hb ? (bf16_t*)(ws + WS_HB) : nullptr, tid, bid, G);
        }
        if (ph + 1 < ph_hi) { if (ph == 0) grid.sync(); else xcd_barrier(xbar); }
    }
}
#ifndef PH_LIMIT
#define PH_LIMIT 28
#endif
constexpr int N_PHASES = PH_LIMIT;

extern "C" void kernel_launch(void* const* d_in, const int* in_sizes, int n_in, void* d_out, int out_size, void* d_ws, size_t ws_size, hipStream_t stream) {
    static int grid = 0;
    if (grid == 0) {
        if (n_in != 19 || out_size != TL * D || ws_size < WS_END) { fprintf(stderr, "kernel_launch: unexpected problem (n_in %d out %d ws %zu need %zu)\n", n_in, out_size, ws_size, (size_t)WS_END); grid = -1; return; }
        int dev = 0, cus = 0, per_cu = 0;
        hipGetDevice(&dev); hipDeviceGetAttribute(&cus, hipDeviceAttributeMultiprocessorCount, dev);
        if (hipFuncSetAttribute((const void*)mega, hipFuncAttributeMaxDynamicSharedMemorySize, LDS_BYTES) != hipSuccess) { fprintf(stderr, "kernel_launch: hipFuncSetAttribute failed\n"); grid = -1; return; }
        if (hipOccupancyMaxActiveBlocksPerMultiprocessor(&per_cu, (const void*)mega, 512, LDS_BYTES) != hipSuccess || per_cu < 1) { fprintf(stderr, "kernel_launch: occupancy query failed (%d)\n", per_cu); (void)hipGetLastError(); per_cu = 1; }
        grid = cus * per_cu;
        if (grid > 256) grid = 256;
    }
    if (grid < 0) return;
    Params p{};
    const float** pp = (const float**)&p;
    for (int i = 0; i < 19; ++i) pp[i] = (const float*)d_in[i];
    p.out = (float*)d_out; p.ws = (unsigned char*)d_ws;
#if MK_MULTI
    for (int ph = 0; ph < N_PHASES; ++ph) { int lo = ph, hi = ph + 1; hipLaunchKernelGGL(mega, dim3(grid), dim3(512), LDS_BYTES, stream, p, lo, hi); }
#else
    int lo = 0, hi = N_PHASES;
    (void)hipMemsetAsync((unsigned char*)d_ws + WS_BAR, 0, XCD_BAR_WORDS * 4, stream);
    void* args[] = {&p, &lo, &hi};
    hipError_t e = hipLaunchCooperativeKernel((const void*)mega, dim3(grid), dim3(512), args, LDS_BYTES, stream);
    if (e != hipSuccess) fprintf(stderr, "cooperative launch failed: %s (grid %d)\n", hipGetErrorString(e), grid);
#endif
}
```
